# Optimizing an MI355X kernel written in HIP

```python
import math
import jax
import jax.numpy as jnp
from jax import lax
import numpy as np

D_MODEL = 1024
BATCH = 4
SEQ = 4096
DEPTH = 2
DEC_BATCH = 32
DEC_SEQ = 4
PAST_LEN = 16384
PAGE_SIZE = 128

HEAD_DIM = 128
N_DIL_HEADS = 4
DIL_GROUPS = ((128, 1), (512, 4), (2048, 16))
N_GROUPS = len(DIL_GROUPS)
DIL_SPAN = 128
ATT_WIDTH = N_DIL_HEADS * HEAD_DIM
N_CROSS_HEADS = 4
CROSS_WIDTH = N_CROSS_HEADS * HEAD_DIM
N_MEM = 256
ROT_DIM = HEAD_DIM // 4
ROPE_THETA = 500000.0
S5_WIDTH = ATT_WIDTH
S5_GROUP = 16
S5_GROUPS = S5_WIDTH // S5_GROUP
S5_STATE = 64
D_FF = 2816
CONV_W = 3
BLOCK = 128
EPS = 1e-6
NEG = -1e30
N_A_LAYERS = (DEPTH + 1) // 2
N_B_LAYERS = DEPTH // 2
QKV_WIDTH = 3 * N_GROUPS * ATT_WIDTH
IN_A = QKV_WIDTH + CROSS_WIDTH
IN_B = S5_WIDTH + CROSS_WIDTH
MIX_OUT = ATT_WIDTH + CROSS_WIDTH
SCALE = HEAD_DIM ** -0.5

kernel_name = 'dilated_s5_hybrid_decode_step'


def rmsnorm(x, g):
    xf = x.astype(jnp.float32)
    y = xf * lax.rsqrt(jnp.mean(xf * xf, axis=-1, keepdims=True) + EPS)
    return (y * g.astype(jnp.float32)).astype(x.dtype)


def rope_partial(x, pos):
    half = ROT_DIM // 2
    inv = jnp.exp(-math.log(ROPE_THETA) * jnp.arange(half, dtype=jnp.float32) / half)
    ang = pos.astype(jnp.float32)[:, None] * inv[None, :]
    cos = jnp.cos(ang)[:, None, :]
    sin = jnp.sin(ang)[:, None, :]
    xf = x.astype(jnp.float32)
    x1, x2, rest = xf[..., :half], xf[..., half:ROT_DIM], xf[..., ROT_DIM:]
    return jnp.concatenate([x1 * cos - x2 * sin, x2 * cos + x1 * sin, rest], axis=-1).astype(x.dtype)


def banded_attention(q, k, v):
    n, l, h, d = q.shape
    nb = -(-l // BLOCK)
    pad = nb * BLOCK - l
    qb = jnp.pad(q.astype(jnp.float32), ((0, 0), (0, pad), (0, 0), (0, 0))).reshape(n, nb, BLOCK, h, d)

    def band(t):
        tp = jnp.pad(t.astype(jnp.float32), ((0, 0), (BLOCK, pad), (0, 0), (0, 0))).reshape(n, nb + 1, BLOCK, h, d)
        return jnp.concatenate([tp[:, :-1], tp[:, 1:]], axis=2)

    kb, vb = band(k), band(v)
    s = jnp.einsum('nbqhd,nbkhd->nbhqk', qb, kb) * SCALE
    qi = jnp.arange(BLOCK)[:, None]
    kj = jnp.arange(2 * BLOCK)[None, :]
    dist = BLOCK + qi - kj
    in_band = (dist >= 0) & (dist <= DIL_SPAN)
    past_ok = (jnp.arange(nb) > 0)[:, None, None] | (kj >= BLOCK)[None]
    mask = in_band[None] & past_ok
    s = jnp.where(mask[None, :, None], s, NEG)
    lse = jax.nn.logsumexp(s, axis=-1)
    p = jnp.exp(s - lse[..., None])
    o = jnp.einsum('nbhqk,nbkhd->nbqhd', p, vb).reshape(n, nb * BLOCK, h, d)[:, :l]
    lse = lse.transpose(0, 1, 3, 2).reshape(n, nb * BLOCK, h)[:, :l]
    return o, lse


def dilated_prompt(q, k, v, r):
    b, s, h, d = q.shape
    l = s // r

    def to_res(t):
        return t.reshape(b, l, r, h, d).transpose(0, 2, 1, 3, 4).reshape(b * r, l, h, d)

    o, lse = banded_attention(to_res(q), to_res(k), to_res(v))
    o = o.reshape(b, r, l, h, d).transpose(0, 2, 1, 3, 4).reshape(b, s, h, d)
    lse = lse.reshape(b, r, l, h).transpose(0, 2, 1, 3).reshape(b, s, h)
    return o, lse


def dilated_sample(q, k, v, kv_buf, r):
    t = q.shape[1]
    lb = kv_buf.shape[1]
    k_all = jnp.concatenate([kv_buf[:, :, 0].astype(jnp.float32), k.astype(jnp.float32)], axis=1)
    v_all = jnp.concatenate([kv_buf[:, :, 1].astype(jnp.float32), v.astype(jnp.float32)], axis=1)
    idx = lb + jnp.arange(t)[:, None] - r * jnp.arange(DIL_SPAN + 1)[None, :]
    valid = idx >= 0
    idx = jnp.maximum(idx, 0)
    kg = k_all[:, idx]
    vg = v_all[:, idx]
    s = jnp.einsum('bthd,btjhd->bthj', q.astype(jnp.float32), kg) * SCALE
    s = jnp.where(valid[None, :, None, :], s, NEG)
    lse = jax.nn.logsumexp(s, axis=-1)
    p = jnp.exp(s - lse[..., None])
    o = jnp.einsum('bthj,btjhd->bthd', p, vg)
    new_buf = jnp.concatenate([kv_buf, jnp.stack([k, v], axis=2).astype(kv_buf.dtype)], axis=1)[:, t:]
    return o, lse, new_buf


def combine_groups(outs, lses):
    wts = jax.nn.softmax(jnp.stack(lses, axis=0), axis=0)
    return jnp.einsum('gnsh,gnshd->nshd', wts, jnp.stack(outs, axis=0))


def s5_mixer(u, s0, lam_re, lam_im, log_dt, b_re, b_im, c_re, c_im, d_skip, w_glu, b_glu):
    n, s, _ = u.shape
    ug = u.astype(jnp.float32).reshape(n, s, S5_GROUPS, S5_GROUP)
    a_re = lam_re.astype(jnp.float32)
    a_im = lam_im.astype(jnp.float32)
    dt = jnp.exp(log_dt.astype(jnp.float32))[:, None]
    mag = jnp.exp(a_re * dt)
    lb_re = mag * jnp.cos(a_im * dt)
    lb_im = mag * jnp.sin(a_im * dt)
    den = a_re * a_re + a_im * a_im
    xr, yi = lb_re - 1.0, lb_im
    f_re = (xr * a_re + yi * a_im) / den
    f_im = (yi * a_re - xr * a_im) / den
    br = b_re.astype(jnp.float32)
    bi = b_im.astype(jnp.float32)
    bb_re = f_re[..., None] * br - f_im[..., None] * bi
    bb_im = f_re[..., None] * bi + f_im[..., None] * br
    bu_re = jnp.einsum('nsgc,gpc->nsgp', ug, bb_re)
    bu_im = jnp.einsum('nsgc,gpc->nsgp', ug, bb_im)
    ar0 = jnp.broadcast_to(lb_re, bu_re.shape)
    ai0 = jnp.broadcast_to(lb_im, bu_re.shape)

    def combine(e1, e2):
        a1r, a1i, b1r, b1i = e1
        a2r, a2i, b2r, b2i = e2
        return (a2r * a1r - a2i * a1i, a2r * a1i + a2i * a1r,
                a2r * b1r - a2i * b1i + b2r, a2r * b1i + a2i * b1r + b2i)

    cr, ci, sr, si = lax.associative_scan(combine, (ar0, ai0, bu_re, bu_im), axis=1)
    if s0 is not None:
        s0r = s0[:, 0].astype(jnp.float32)[:, None]
        s0i = s0[:, 1].astype(jnp.float32)[:, None]
        sr, si = sr + cr * s0r - ci * s0i, si + cr * s0i + ci * s0r
    y = (jnp.einsum('nsgp,gcp->nsgc', sr, c_re.astype(jnp.float32))
         - jnp.einsum('nsgp,gcp->nsgc', si, c_im.astype(jnp.float32))
         + d_skip.astype(jnp.float32) * ug).reshape(n, s, S5_WIDTH)
    y = jax.nn.gelu(y)
    out = y * jax.nn.sigmoid(y @ w_glu.astype(jnp.float32) + b_glu.astype(jnp.float32))
    state = jnp.stack([sr[:, -1], si[:, -1]], axis=1)
    return out.astype(u.dtype), state.astype(u.dtype)


def memory_kv(mem, g_mem, w_kv, g_k):
    n, m, _ = mem.shape
    kv = (rmsnorm(mem, g_mem) @ w_kv).reshape(n, m, 2, N_CROSS_HEADS, HEAD_DIM)
    return jnp.stack([rmsnorm(kv[:, :, 0], g_k), kv[:, :, 1]], axis=2)


def cross_attn(qc, kv, g_q):
    n, s, _ = qc.shape
    q = rmsnorm(qc.reshape(n, s, N_CROSS_HEADS, HEAD_DIM), g_q).astype(jnp.float32)
    sc = jnp.einsum('nshd,nmhd->nhsm', q, kv[:, :, 0].astype(jnp.float32)) * SCALE
    p = jax.nn.softmax(sc, axis=-1)
    o = jnp.einsum('nhsm,nmhd->nshd', p, kv[:, :, 1].astype(jnp.float32))
    return o.reshape(n, s, CROSS_WIDTH)


def conv_ffn(h, buf, w_up, conv_w, conv_b, w_down):
    s = h.shape[1]
    up = h @ w_up
    ext = jnp.concatenate([buf.astype(up.dtype), up], axis=1)
    c = conv_b
    for j in range(CONV_W):
        c = c + conv_w[j] * ext[:, j:j + s]
    a, b = jnp.split(c, 2, axis=-1)
    return (jax.nn.silu(a) * b) @ w_down, ext[:, s:]


def trunk(x, pos, p, mem=None, win_in=None, mem_kv_in=None, s5_in=None, conv_in=None):
    is_prompt = win_in is None
    n, s, _ = x.shape
    new_win = [[] for _ in range(N_GROUPS)]
    new_mem, new_s5, new_conv = [], [], []
    for i in range(DEPTH):
        h = rmsnorm(x, p['g_mix'][i])
        if is_prompt:
            kv_m = memory_kv(mem, p['g_mem'][i], p['w_mem_kv'][i], p['g_k_cross'][i])
            new_mem.append(kv_m)
        else:
            kv_m = mem_kv_in[i]
        if i % 2 == 0:
            ia = i // 2
            proj = h @ p['w_in_a'][ia]
            qkv = proj[..., :QKV_WIDTH].reshape(n, s, 3, N_GROUPS, N_DIL_HEADS, HEAD_DIM)
            qc = proj[..., QKV_WIDTH:]
            outs, lses = [], []
            for g, (w, r) in enumerate(DIL_GROUPS):
                q = rope_partial(rmsnorm(qkv[:, :, 0, g], p['g_q_dil'][ia, g]), pos)
                k = rope_partial(rmsnorm(qkv[:, :, 1, g], p['g_k_dil'][ia, g]), pos)
                v = qkv[:, :, 2, g]
                if is_prompt:
                    o, l = dilated_prompt(q, k, v, r)
                    keep = min(w, s)
                    new_win[g].append(jnp.stack([k, v], axis=2)[:, s - keep:])
                else:
                    o, l, nbuf = dilated_sample(q, k, v, win_in[g][ia], r)
                    new_win[g].append(nbuf)
                outs.append(o)
                lses.append(l)
            mix = combine_groups(outs, lses).reshape(n, s, ATT_WIDTH)
        else:
            ib = i // 2
            proj = h @ p['w_in_b'][ib]
            u = proj[..., :S5_WIDTH]
            qc = proj[..., S5_WIDTH:]
            s0 = None if is_prompt else s5_in[ib]
            mix, s_last = s5_mixer(u, s0, p['s5_lam_re'][ib], p['s5_lam_im'][ib], p['s5_log_dt'][ib],
                                   p['s5_b_re'][ib], p['s5_b_im'][ib], p['s5_c_re'][ib], p['s5_c_im'][ib],
                                   p['s5_d'][ib], p['w_glu'][ib], p['b_glu'][ib])
            new_s5.append(s_last)
        cross = cross_attn(qc, kv_m, p['g_q_cross'][i])
        merged = jnp.concatenate([mix.astype(x.dtype), cross.astype(x.dtype)], axis=-1)
        x = x + merged @ p['w_out'][i]
        h = rmsnorm(x, p['g_ffn'][i])
        buf = jnp.zeros((n, CONV_W - 1, 2 * D_FF), x.dtype) if is_prompt else conv_in[i]
        f, nconv = conv_ffn(h, buf, p['w_up'][i], p['conv_w'][i], p['conv_b'][i], p['w_down'][i])
        new_conv.append(nconv)
        x = x + f
    wins = [jnp.stack(nw, axis=0) for nw in new_win]
    mem_out = jnp.stack(new_mem, axis=0) if is_prompt else None
    return x, wins, mem_out, jnp.stack(new_s5, axis=0), jnp.stack(new_conv, axis=0)


def setup_inputs(seed: int = 0) -> dict:
    key = jax.random.key(seed)
    ks = iter(jax.random.split(key, 48))

    def nrm(shape, scale):
        return scale * jax.random.normal(next(ks), shape, jnp.float32)

    def gain(shape):
        return 1.0 + 0.05 * jax.random.normal(next(ks), shape, jnp.float32)

    lw = [min(w, PAST_LEN) for w, _ in DIL_GROUPS]
    kv_tail = (2, N_DIL_HEADS, HEAD_DIM)
    n_idx = jnp.arange(S5_STATE, dtype=jnp.float32)
    return {
        'x_prompt': nrm((BATCH, SEQ, D_MODEL), 1.0),
        'x_sample': nrm((DEC_BATCH, DEC_SEQ, D_MODEL), 1.0),
        'cache_win0_kv': nrm((N_A_LAYERS, DEC_BATCH, lw[0]) + kv_tail, 1.0),
        'cache_win1_kv': nrm((N_A_LAYERS, DEC_BATCH, lw[1]) + kv_tail, 1.0),
        'cache_win2_kv': nrm((N_A_LAYERS, DEC_BATCH, lw[2]) + kv_tail, 1.0),
        'cache_mem_kv': nrm((DEPTH, DEC_BATCH, N_MEM, 2, N_CROSS_HEADS, HEAD_DIM), 1.0),
        'state_s5': nrm((N_B_LAYERS, DEC_BATCH, 2, S5_GROUPS, S5_STATE), 0.1),
        'state_ffn_conv': nrm((DEPTH, DEC_BATCH, CONV_W - 1, 2 * D_FF), 1.0),
        'mem_prompt': nrm((BATCH, N_MEM, D_MODEL), 1.0),
        'g_mix': gain((DEPTH, D_MODEL)),
        'g_ffn': gain((DEPTH, D_MODEL)),
        'w_in_a': nrm((N_A_LAYERS, D_MODEL, IN_A), D_MODEL ** -0.5),
        'g_q_dil': gain((N_A_LAYERS, N_GROUPS, HEAD_DIM)),
        'g_k_dil': gain((N_A_LAYERS, N_GROUPS, HEAD_DIM)),
        'w_in_b': nrm((N_B_LAYERS, D_MODEL, IN_B), D_MODEL ** -0.5),
        's5_lam_re': -0.5 * jnp.exp(0.05 * jax.random.normal(next(ks), (N_B_LAYERS, S5_GROUPS, S5_STATE), jnp.float32)),
        's5_lam_im': math.pi * n_idx + 0.01 * jax.random.normal(next(ks), (N_B_LAYERS, S5_GROUPS, S5_STATE), jnp.float32),
        's5_log_dt': jax.random.uniform(next(ks), (N_B_LAYERS, S5_GROUPS), jnp.float32, math.log(0.001), math.log(0.1)),
        's5_b_re': nrm((N_B_LAYERS, S5_GROUPS, S5_STATE, S5_GROUP), (2 * S5_GROUP) ** -0.5),
        's5_b_im': nrm((N_B_LAYERS, S5_GROUPS, S5_STATE, S5_GROUP), (2 * S5_GROUP) ** -0.5),
        's5_c_re': nrm((N_B_LAYERS, S5_GROUPS, S5_GROUP, S5_STATE), (2 * S5_STATE) ** -0.5),
        's5_c_im': nrm((N_B_LAYERS, S5_GROUPS, S5_GROUP, S5_STATE), (2 * S5_STATE) ** -0.5),
        's5_d': nrm((N_B_LAYERS, S5_GROUPS, S5_GROUP), 1.0),
        'w_glu': nrm((N_B_LAYERS, S5_WIDTH, S5_WIDTH), S5_WIDTH ** -0.5),
        'b_glu': nrm((N_B_LAYERS, S5_WIDTH), 0.02),
        'g_mem': gain((DEPTH, D_MODEL)),
        'w_mem_kv': nrm((DEPTH, D_MODEL, 2 * CROSS_WIDTH), D_MODEL ** -0.5),
        'g_q_cross': gain((DEPTH, HEAD_DIM)),
        'g_k_cross': gain((DEPTH, HEAD_DIM)),
        'w_out': nrm((DEPTH, MIX_OUT, D_MODEL), MIX_OUT ** -0.5),
        'w_up': nrm((DEPTH, D_MODEL, 2 * D_FF), D_MODEL ** -0.5),
        'conv_w': nrm((DEPTH, CONV_W, 2 * D_FF), CONV_W ** -0.5),
        'conv_b': nrm((DEPTH, 2 * D_FF), 0.02),
        'w_down': nrm((DEPTH, D_FF, D_MODEL), D_FF ** -0.5),
    }


def reference(x_prompt, x_sample, cache_win0_kv, cache_win1_kv, cache_win2_kv, cache_mem_kv,
              state_s5, state_ffn_conv, mem_prompt, g_mix, g_ffn, w_in_a, g_q_dil, g_k_dil, w_in_b,
              s5_lam_re, s5_lam_im, s5_log_dt, s5_b_re, s5_b_im, s5_c_re, s5_c_im, s5_d, w_glu, b_glu,
              g_mem, w_mem_kv, g_q_cross, g_k_cross, w_out, w_up, conv_w, conv_b, w_down):
    params = dict(g_mix=g_mix, g_ffn=g_ffn, w_in_a=w_in_a, g_q_dil=g_q_dil, g_k_dil=g_k_dil,
                  w_in_b=w_in_b, s5_lam_re=s5_lam_re, s5_lam_im=s5_lam_im, s5_log_dt=s5_log_dt,
                  s5_b_re=s5_b_re, s5_b_im=s5_b_im, s5_c_re=s5_c_re, s5_c_im=s5_c_im, s5_d=s5_d,
                  w_glu=w_glu, b_glu=b_glu, g_mem=g_mem, w_mem_kv=w_mem_kv, g_q_cross=g_q_cross,
                  g_k_cross=g_k_cross, w_out=w_out, w_up=w_up, conv_w=conv_w, conv_b=conv_b,
                  w_down=w_down)
    pos_p = jnp.arange(x_prompt.shape[1], dtype=jnp.int32)
    pos_s = PAST_LEN + jnp.arange(x_sample.shape[1], dtype=jnp.int32)
    y_prompt, win_p, mem_p, s5_p, conv_p = trunk(x_prompt, pos_p, params, mem=mem_prompt)
    y_sample, win_s, _, s5_s, conv_s = trunk(
        x_sample, pos_s, params,
        win_in=(cache_win0_kv, cache_win1_kv, cache_win2_kv),
        mem_kv_in=cache_mem_kv, s5_in=state_s5, conv_in=state_ffn_conv)
    return (y_prompt, y_sample, win_p[0], win_p[1], win_p[2], mem_p, s5_p, conv_p,
            win_s[0], win_s[1], win_s[2], s5_s, conv_s)
```

```cpp
#include <hip/hip_runtime.h>
#include <hip/hip_cooperative_groups.h>
#include <cstdio>
#include <cstdint>
namespace cg = cooperative_groups;
#ifndef MK_N_LAUNCHES
#define MK_N_LAUNCHES 17
#endif
namespace pg8 {
#define PG8_LAS __attribute__((address_space(3)))
typedef unsigned short bf16_t;
typedef short bf16x8 __attribute__((ext_vector_type(8)));
typedef float f32x4 __attribute__((ext_vector_type(4)));
typedef unsigned u32x4 __attribute__((ext_vector_type(4)));
constexpr int BM = 256, BK = 64, HALF = 128, HTB = HALF * BK * 2  , STAGE_BYTES = 8 * HTB, NXCD = 8, WGM = 8;

__host__ __device__ __forceinline__ int lds_byte(int r, int c) { const int st = (r >> 4) * 2 + (c >> 5), rr = r & 15, cc = c & 31, ob = rr * 64 + cc * 2; return st * 1024 + (ob ^ (((ob >> 9) & 1) << 5)); }
__host__ __device__ __forceinline__ void stage_rc(int b, int& R, int& C) { const int st = b / 1024, sb = b % 1024, swz = sb ^ (((sb >> 9) & 1) << 5); R = (st >> 1) * 16 + swz / 64; C = (st & 1) * 32 + (swz % 64) / 2; }
__host__ __device__ __forceinline__ int perm32(int rho) { const int n = rho >> 4, i = rho & 15; return 8 * (i >> 2) + 4 * n + (i & 3); }

struct Unit { int pm, pn; };
struct Gemm { const bf16_t* A; const bf16_t* Bt; int M, N, K; };

struct StaticOrder {
    int nM, nN, nwg, G, c;
    __host__ __device__ void init(int M, int N, int G_, int c_) { nM = M / BM; nN = N / BM; nwg = nM * nN; G = G_; c = c_; }
    __host__ __device__ bool next(int i, Unit& u) const {
        const long L = (long)i * G + c; if (L >= nwg) return false;
        int wgid = (int)L; { const int q = nwg / NXCD, r = nwg % NXCD, xcd = wgid % NXCD, off = wgid / NXCD; wgid = (xcd < r ? xcd * (q + 1) : r * (q + 1) + (xcd - r) * q) + off; }
        const int nig = WGM * nN, gid = wgid / nig, fm = gid * WGM, gsz = (nM - fm) < WGM ? (nM - fm) : WGM;
        u.pm = fm + ((wgid % nig) % gsz); u.pn = (wgid % nig) / gsz; return true;
    }
    __device__ __forceinline__ void a_ready(const Unit&) const {}
    __device__ __forceinline__ void done(const Unit&) const {}
};

__device__ __forceinline__ unsigned cvt_pk_bf16(float lo, float hi) { typedef float f2_ __attribute__((ext_vector_type(2))); typedef __bf16 b2_ __attribute__((ext_vector_type(2))); f2_ v = {lo, hi}; b2_ b = __builtin_convertvector(v, b2_); return __builtin_bit_cast(unsigned, b); }
template <class Epi, class Sched, bool ALIGN_EPI = false, bool SP2 = false>
__device__ __forceinline__ void gemm_phase(PG8_LAS unsigned char* lds, const Gemm g, const Sched& S, const Epi& E) {
    const int tid = threadIdx.x, wid = __builtin_amdgcn_readfirstlane(tid >> 6), lane = tid & 63, wr = wid >> 2, wc = wid & 3, fr = lane & 15, fq = lane >> 4;
    const int K = g.K, nt = K / BK;
    unsigned voffA[2], voffB[2];
#pragma unroll
    for (int i = 0; i < 2; ++i) { int R, C; stage_rc(tid * 16 + i * 8192, R, C); const int Rb = Epi::PERM ? ((R & ~31) + perm32(R & 31)) : R;
        voffA[i] = (unsigned)(R * K + C) * 2u; voffB[i] = (unsigned)(Rb * K + C) * 2u; }
    const size_t kstep = (size_t)(BK * 2);
    const size_t hstep = (size_t)HALF * K * 2;
    const size_t tstep = 2 * hstep;
    const unsigned ldsw = (unsigned)wid * 1024u;
    const int aoff = lds_byte(wr * 64 + fr, fq * 8), boff = lds_byte(wc * 32 + fr, fq * 8);
#define PG8_SA(b, h) (((b) * 2 + (h)) * HTB)
#define PG8_SB(b, h) ((4 + (b) * 2 + (h)) * HTB)
#define PG8_STAGE(bufoff, gbase, voff) do { _Pragma("unroll") for (int _i = 0; _i < 2; ++_i) \
        __builtin_amdgcn_global_load_lds((const unsigned*)((const char*)(gbase) + (voff)[_i]), (PG8_LAS unsigned*)(lds + (bufoff) + ldsw + _i * 8192), 16, 0, 0); } while (0)
#define PG8_LDA(dst, b, h) do { _Pragma("unroll") for (int m = 0; m < 4; ++m) _Pragma("unroll") for (int k = 0; k < 2; ++k) dst[m][k] = *(const PG8_LAS bf16x8*)(lds + PG8_SA(b, h) + aoff + m * 2048 + k * 1024); } while (0)
#define PG8_LDB(dst, b, h) do { _Pragma("unroll") for (int n = 0; n < 2; ++n) _Pragma("unroll") for (int k = 0; k < 2; ++k) dst[n][k] = *(const PG8_LAS bf16x8*)(lds + PG8_SB(b, h) + boff + n * 2048 + k * 1024); } while (0)
#define PG8_MMA(ai, bj, At, Bt) do { __builtin_amdgcn_s_setprio(1); _Pragma("unroll") for (int m = 0; m < 4; ++m) _Pragma("unroll") for (int n = 0; n < 2; ++n) _Pragma("unroll") for (int k = 0; k < 2; ++k) \
        acc[ai][bj][m][n] = __builtin_amdgcn_mfma_f32_16x16x32_bf16(Bt[n][k], At[m][k], acc[ai][bj][m][n], 0, 0, 0); __builtin_amdgcn_s_setprio(0); } while (0)
#define PG8_WAIT_V(n) asm volatile("s_waitcnt vmcnt(" #n ")" ::: "memory")
#define PG8_WAIT_L(n) asm volatile("s_waitcnt lgkmcnt(" #n ")" ::: "memory")
#define PG8_BAR __builtin_amdgcn_s_barrier()
#define PG8_SCHED __builtin_amdgcn_sched_barrier(0)
    Unit cur, nxt; int ui = 0;
    if (!S.next(0, cur)) return;
    f32x4 acc[2][2][4][2];
#pragma unroll
    for (int a = 0; a < 2; ++a)
#pragma unroll
        for (int b = 0; b < 2; ++b)
#pragma unroll
            for (int m = 0; m < 4; ++m)
#pragma unroll
                for (int n = 0; n < 2; ++n) acc[a][b][m][n] = (f32x4){0.f, 0.f, 0.f, 0.f};
    bf16x8 At[4][2], B0[2][2], B1[2][2];
    const char* cA = (const char*)g.A + (size_t)cur.pm * tstep; const char* cB = (const char*)g.Bt + (size_t)cur.pn * tstep;
    S.a_ready(cur);
    if constexpr (SP2) {
        PG8_STAGE(PG8_SB(0, 0), cB, voffB); PG8_STAGE(PG8_SB(0, 1), cB + hstep, voffB); PG8_STAGE(PG8_SA(0, 0), cA, voffA); PG8_STAGE(PG8_SA(0, 1), cA + hstep, voffA);
        if (wr == 1) PG8_BAR;
        PG8_WAIT_V(2); PG8_BAR;
        PG8_STAGE(PG8_SB(1, 0), cB + kstep, voffB); PG8_STAGE(PG8_SA(1, 0), cA + kstep, voffA); PG8_STAGE(PG8_SB(1, 1), cB + hstep + kstep, voffB);
        PG8_WAIT_V(6); PG8_BAR;
    } else {
        PG8_STAGE(PG8_SB(0, 0), cB, voffB); PG8_STAGE(PG8_SA(0, 0), cA, voffA); PG8_STAGE(PG8_SB(0, 1), cB + hstep, voffB); PG8_STAGE(PG8_SA(0, 1), cA + hstep, voffA);
        if (wr == 1) PG8_BAR;
        PG8_WAIT_V(4); PG8_BAR;
        PG8_STAGE(PG8_SB(1, 0), cB + kstep, voffB); PG8_STAGE(PG8_SA(1, 0), cA + kstep, voffA); PG8_STAGE(PG8_SB(1, 1), cB + hstep + kstep, voffB);
        PG8_WAIT_V(6); PG8_BAR;
    }
    for (;;) {
        const bool has_next = S.next(ui + 1, nxt);
        const char* nA = has_next ? (const char*)g.A + (size_t)nxt.pm * tstep : cA; const char* nB = has_next ? (const char*)g.Bt + (size_t)nxt.pn * tstep : cB;
        for (int t = 0; t < nt; t += 2) {
            const bool last = (t == nt - 2);
            const char* a1 = cA + (size_t)(t + 1) * kstep;
            const char* a2 = last ? nA : cA + (size_t)(t + 2) * kstep; const char* b2 = last ? nB : cB + (size_t)(t + 2) * kstep;
            const char* a3 = a2 + kstep; const char* b3 = b2 + kstep;
            if (last && has_next) S.a_ready(nxt);
            if constexpr (SP2) {
            PG8_LDB(B0, 0, 0); PG8_LDB(B1, 0, 1); PG8_SCHED; PG8_LDA(At, 0, 0); PG8_STAGE(PG8_SA(1, 1), a1 + hstep, voffA);
            PG8_WAIT_V(8); PG8_WAIT_L(0); PG8_BAR; PG8_MMA(0, 0, At, B0); PG8_MMA(0, 1, At, B1); PG8_BAR; PG8_SCHED;
            PG8_LDA(At, 0, 1); PG8_STAGE(PG8_SB(0, 0), b2, voffB); PG8_STAGE(PG8_SB(0, 1), b2 + hstep, voffB); PG8_STAGE(PG8_SA(0, 0), a2, voffA);
            PG8_WAIT_V(8); PG8_WAIT_L(0); PG8_BAR; PG8_MMA(1, 0, At, B0); PG8_MMA(1, 1, At, B1); PG8_BAR; PG8_SCHED;
            PG8_LDB(B0, 1, 0); PG8_LDB(B1, 1, 1); PG8_SCHED; PG8_LDA(At, 1, 0); PG8_STAGE(PG8_SA(0, 1), a2 + hstep, voffA);
            PG8_WAIT_V(8); PG8_WAIT_L(0); PG8_BAR; PG8_MMA(0, 0, At, B0); PG8_MMA(0, 1, At, B1); PG8_BAR; PG8_SCHED;
            PG8_LDA(At, 1, 1); PG8_STAGE(PG8_SB(1, 0), b3, voffB); PG8_STAGE(PG8_SB(1, 1), b3 + hstep, voffB); PG8_STAGE(PG8_SA(1, 0), a3, voffA);
            PG8_WAIT_V(8); PG8_WAIT_L(0); PG8_BAR; PG8_MMA(1, 0, At, B0); PG8_MMA(1, 1, At, B1); PG8_BAR; PG8_SCHED;
            } else {
            PG8_LDB(B0, 0, 0); PG8_SCHED; PG8_LDA(At, 0, 0); PG8_STAGE(PG8_SA(1, 1), a1 + hstep, voffA);
            PG8_WAIT_L(8); PG8_BAR; PG8_WAIT_L(0); PG8_MMA(0, 0, At, B0); PG8_BAR; PG8_SCHED;
            PG8_LDB(B1, 0, 1); PG8_STAGE(PG8_SB(0, 0), b2, voffB);
            PG8_BAR; PG8_WAIT_L(0); PG8_MMA(0, 1, At, B1); PG8_BAR;
            PG8_LDA(At, 0, 1); PG8_STAGE(PG8_SA(0, 0), a2, voffA);
            PG8_BAR; PG8_WAIT_L(0); PG8_MMA(1, 0, At, B0); PG8_BAR; PG8_SCHED;
            PG8_STAGE(PG8_SB(0, 1), b2 + hstep, voffB);
            PG8_WAIT_V(6); PG8_BAR; PG8_MMA(1, 1, At, B1); PG8_BAR;
            PG8_LDB(B0, 1, 0); PG8_SCHED; PG8_LDA(At, 1, 0); PG8_STAGE(PG8_SA(0, 1), a2 + hstep, voffA);
            PG8_WAIT_L(8); PG8_BAR; PG8_WAIT_L(0); PG8_MMA(0, 0, At, B0); PG8_BAR; PG8_SCHED;
            PG8_LDB(B1, 1, 1); PG8_STAGE(PG8_SB(1, 0), b3, voffB);
            PG8_BAR; PG8_WAIT_L(0); PG8_MMA(0, 1, At, B1); PG8_BAR;
            PG8_LDA(At, 1, 1); PG8_STAGE(PG8_SA(1, 0), a3, voffA);
            PG8_BAR; PG8_WAIT_L(0); PG8_MMA(1, 0, At, B0); PG8_BAR; PG8_SCHED;
            PG8_STAGE(PG8_SB(1, 1), b3 + hstep, voffB);
            PG8_WAIT_V(6); PG8_BAR; PG8_MMA(1, 1, At, B1); PG8_BAR;
            }
        }
        if constexpr (ALIGN_EPI) { if (wr == 0) PG8_BAR; }
        if constexpr (!Epi::AFTER_DRAIN) { E(acc, cur, wr, wc, fr, fq); S.done(cur); }
        if (!has_next) break;
#pragma unroll
        for (int a = 0; a < 2; ++a)
#pragma unroll
            for (int b = 0; b < 2; ++b)
#pragma unroll
                for (int m = 0; m < 4; ++m)
#pragma unroll
                    for (int n = 0; n < 2; ++n) acc[a][b][m][n] = (f32x4){0.f, 0.f, 0.f, 0.f};
        cur = nxt; cA = nA; cB = nB; ++ui;
        if constexpr (ALIGN_EPI) { if (wr == 1) PG8_BAR; }
    }
    PG8_WAIT_V(0);
    if constexpr (!ALIGN_EPI) { if (wr == 0) PG8_BAR; }
    PG8_BAR;
    if constexpr (Epi::AFTER_DRAIN) { E.fused(acc, cur, wr, wc, fr, fq, lds, wid, lane); S.done(cur); }
#undef PG8_SA
#undef PG8_SB
#undef PG8_STAGE
#undef PG8_LDA
#undef PG8_LDB
#undef PG8_MMA
#undef PG8_WAIT_V
#undef PG8_WAIT_L
#undef PG8_BAR
#undef PG8_SCHED
}
}

#define LAS __attribute__((address_space(3)))
typedef unsigned short bf16_t;
typedef float f32x4 __attribute__((ext_vector_type(4)));
typedef float f32x2 __attribute__((ext_vector_type(2)));
typedef unsigned u32x4 __attribute__((ext_vector_type(4)));
typedef unsigned u32x2 __attribute__((ext_vector_type(2)));
typedef short bf16x8 __attribute__((ext_vector_type(8)));
typedef short s16x4 __attribute__((ext_vector_type(4)));

constexpr int DM = 1024, SEQ = 4096, NB = 4, MP = NB * SEQ;
constexpr int DB = 32, DS = 4, MS = DB * DS;
constexpr int MT = MP + MS;
constexpr int MPAD = 16640;
constexpr int PAST = 16384;
constexpr int NIN_A = 5120, DFF = 2816, NUP = 2 * DFF;
constexpr float EPS = 1e-6f;
constexpr float QSCALE = 0.08838834764831845f * 1.4426950408889634f;
constexpr float NEGBIG = -1e30f;

constexpr size_t O_YP = 0;
constexpr size_t O_YS = O_YP + (size_t)MP * DM;
constexpr size_t O_PW0 = O_YS + (size_t)MS * DM;
constexpr size_t O_PW1 = O_PW0 + (size_t)NB * 128 * 1024;
constexpr size_t O_PW2 = O_PW1 + (size_t)NB * 512 * 1024;
constexpr size_t O_PMEM = O_PW2 + (size_t)NB * 2048 * 1024;
constexpr size_t O_PS5 = O_PMEM + (size_t)2 * NB * 256 * 1024;
constexpr size_t O_PCONV = O_PS5 + (size_t)NB * 2 * 32 * 64;
constexpr size_t O_SW0 = O_PCONV + (size_t)2 * NB * 2 * NUP;
constexpr size_t O_SW1 = O_SW0 + (size_t)DB * 128 * 1024;
constexpr size_t O_SW2 = O_SW1 + (size_t)DB * 512 * 1024;
constexpr size_t O_SS5 = O_SW2 + (size_t)DB * 2048 * 1024;
constexpr size_t O_SCONV = O_SS5 + (size_t)DB * 2 * 32 * 64;
constexpr size_t O_END = O_SCONV + (size_t)2 * DB * 2 * NUP;
static_assert(O_END == 119054336, "output size");

constexpr size_t al256(size_t x) { return (x + 255) & ~(size_t)255; }
constexpr size_t WS_SUMSQ = 0;
constexpr size_t WS_WINA = 1u << 20;
constexpr size_t WS_WINB = WS_WINA + (size_t)NIN_A * DM * 2;
constexpr size_t WS_WGLU = WS_WINB + (size_t)DM * DM * 2;
constexpr size_t WS_WMKV = WS_WGLU + (size_t)512 * 512 * 2;
constexpr size_t WS_WOUT = WS_WMKV + (size_t)2 * DM * DM * 2;
constexpr size_t WS_WUP = WS_WOUT + (size_t)2 * DM * DM * 2;
constexpr size_t WS_WDN = WS_WUP + (size_t)2 * NUP * DM * 2;
constexpr size_t WS_HB = WS_WDN + (size_t)2 * DM * DFF * 2;
constexpr size_t WS_MEMN = WS_HB + (size_t)MPAD * DM * 2;
constexpr size_t WS_MKVR = WS_MEMN + (size_t)2 * DM * DM * 2;
constexpr size_t WS_MKV = WS_MKVR + (size_t)2 * DM * DM * 2;
constexpr size_t WS_SMKV = WS_MKV + (size_t)2 * DM * DM * 2;
constexpr size_t WS_PROJ = WS_SMKV + (size_t)2 * DB * 256 * 1024 * 2;
constexpr size_t WS_PROJ1 = WS_PROJ + (size_t)MPAD * NUP * 2;
constexpr size_t WS_OG = WS_PROJ1 + (size_t)MPAD * DM * 2;
constexpr size_t WS_L2G = WS_OG + (size_t)3 * MT * 512 * 2;
constexpr size_t WS_MERGED = al256(WS_L2G + (size_t)3 * MT * 4 * 4);
constexpr size_t WS_X = WS_MERGED + (size_t)MPAD * DM * 2;
constexpr size_t WS_ACT = WS_X + (size_t)MPAD * DM * 4;
constexpr size_t WS_Y = WS_ACT + (size_t)MPAD * DFF * 2;
constexpr size_t WS_E = WS_Y + (size_t)MPAD * 512 * 2;
constexpr size_t WS_END = WS_E + (size_t)NB * 64 * 32 * 64 * 8;
static_assert(WS_END < (size_t)1000 * 1024 * 1024, "ws map");

constexpr int LDS_BYTES = 147456;

struct Args { const float* in[34]; float* out; unsigned char* ws; int ph_lo, ph_hi; };

__device__ __forceinline__ unsigned pk2(float lo, float hi) { return pg8::cvt_pk_bf16(lo, hi); }
__device__ __forceinline__ float bflo(unsigned w) { return __uint_as_float(w << 16); }
__device__ __forceinline__ float bfhi(unsigned w) { return __uint_as_float(w & 0xffff0000u); }
__device__ __forceinline__ float bf2f(bf16_t h) { return __uint_as_float(((unsigned)h) << 16); }
__device__ __forceinline__ bf16_t f2bf(float f) { return (bf16_t)(pk2(f, 0.f) & 0xffffu); }
__device__ __forceinline__ float wave_sum(float v) {
#pragma unroll
    for (int o = 1; o < 64; o <<= 1) v += __shfl_xor(v, o);
    return v;
}
__device__ __forceinline__ float wave_max(float v) {
#pragma unroll
    for (int o = 1; o < 64; o <<= 1) v = fmaxf(v, __shfl_xor(v, o));
    return v;
}
#define LDS_WAIT() asm volatile("s_waitcnt lgkmcnt(0)" ::: "memory")

struct EpiStoreBf16 {
    static constexpr bool PERM = true, AFTER_DRAIN = false;
    bf16_t* O; int ldc; const float* sumsq;
    __device__ __forceinline__ void operator()(const f32x4 (&acc)[2][2][4][2], const pg8::Unit& u, int wr, int wc, int fr, int fq) const {
        const int row0 = u.pm * 256 + wr * 64 + fr, col0 = u.pn * 256 + wc * 32 + 8 * fq;
#pragma unroll
        for (int ai = 0; ai < 2; ++ai)
#pragma unroll
            for (int m = 0; m < 4; ++m) {
                const int row = row0 + ai * 128 + m * 16;
                float sc = 1.f; if (sumsq) sc = rsqrtf(sumsq[row] * (1.f / 1024.f) + EPS);
                bf16_t* rowp = O + (size_t)row * ldc + col0;
#pragma unroll
                for (int bj = 0; bj < 2; ++bj) { const f32x4 v0 = acc[ai][bj][m][0] * sc, v1 = acc[ai][bj][m][1] * sc;
                    u32x4 w; w.x = pk2(v0[0], v0[1]); w.y = pk2(v0[2], v0[3]); w.z = pk2(v1[0], v1[1]); w.w = pk2(v1[2], v1[3]);
                    *(u32x4*)(rowp + bj * 128) = w; }
            }
    }
};
struct EpiGlu {
    static constexpr bool PERM = true, AFTER_DRAIN = false;
    bf16_t* O; int ldc; const bf16_t* Y; const float* bias;
    __device__ __forceinline__ void operator()(const f32x4 (&acc)[2][2][4][2], const pg8::Unit& u, int wr, int wc, int fr, int fq) const {
        const int row0 = u.pm * 256 + wr * 64 + fr, col0 = u.pn * 256 + wc * 32 + 8 * fq;
#pragma unroll
        for (int bj = 0; bj < 2; ++bj) {
            const f32x4 b0 = *(const f32x4*)(bias + col0 + bj * 128), b1 = *(const f32x4*)(bias + col0 + bj * 128 + 4);
#pragma unroll
            for (int ai = 0; ai < 2; ++ai)
#pragma unroll
                for (int m = 0; m < 4; ++m) {
                    const int row = row0 + ai * 128 + m * 16;
                    const u32x4 yw = *(const u32x4*)(Y + (size_t)row * 512 + col0 + bj * 128);
                    const f32x4 z0 = acc[ai][bj][m][0] + b0, z1 = acc[ai][bj][m][1] + b1;
                    float y[8] = {bflo(yw.x), bfhi(yw.x), bflo(yw.y), bfhi(yw.y), bflo(yw.z), bfhi(yw.z), bflo(yw.w), bfhi(yw.w)};
                    float o[8];
#pragma unroll
                    for (int e = 0; e < 4; ++e) { o[e] = y[e] / (1.f + __expf(-z0[e])); o[4 + e] = y[4 + e] / (1.f + __expf(-z1[e])); }
                    u32x4 w; w.x = pk2(o[0], o[1]); w.y = pk2(o[2], o[3]); w.z = pk2(o[4], o[5]); w.w = pk2(o[6], o[7]);
                    *(u32x4*)(O + (size_t)row * ldc + col0 + bj * 128) = w;
                }
        }
    }
};
struct EpiResidual {
    static constexpr bool PERM = false, AFTER_DRAIN = false;
    const float* base_p; const float* base_s; float* out_p; float* out_s; float* sumsq; bf16_t* hb; const float* g;
    __device__ __forceinline__ void operator()(const f32x4 (&acc)[2][2][4][2], const pg8::Unit& u, int wr, int wc, int fr, int fq) const {
        const int col0 = u.pn * 256 + wc * 32 + 4 * fq;
#pragma unroll
        for (int ai = 0; ai < 2; ++ai)
#pragma unroll
            for (int m = 0; m < 4; ++m) {
                const int row = u.pm * 256 + ai * 128 + wr * 64 + m * 16 + fr;
                float ss = 0.f;
                if (row < MT) {
                    const float* b = row < MP ? base_p + (size_t)row * DM : base_s + (size_t)(row - MP) * DM;
                    float* o = row < MP ? out_p + (size_t)row * DM : out_s + (size_t)(row - MP) * DM;
#pragma unroll
                    for (int bj = 0; bj < 2; ++bj)
#pragma unroll
                        for (int n = 0; n < 2; ++n) { const int c = col0 + bj * 128 + n * 16;
                            const f32x4 v = acc[ai][bj][m][n] + *(const f32x4*)(b + c);
                            *(f32x4*)(o + c) = v; ss += (v[0] * v[0] + v[1] * v[1]) + (v[2] * v[2] + v[3] * v[3]);
                            if (hb) { const f32x4 gv = *(const f32x4*)(g + c); u32x2 w; w.x = pk2(v[0] * gv[0], v[1] * gv[1]); w.y = pk2(v[2] * gv[2], v[3] * gv[3]);
                                *(u32x2*)(hb + (size_t)row * DM + c) = w; } }
                }
                ss += __shfl_xor(ss, 16); ss += __shfl_xor(ss, 32);
                if (sumsq && fq == 0 && row < MT) atomicAdd(sumsq + row, ss);
            }
    }
};

__device__ __forceinline__ void transpose_item(const float* W, int K, int N, bf16_t* WT, LAS float* scr, int item, int lane) {
    const int nblk = N / 32, kb = item / nblk, nb = item % nblk, k0 = 64 * kb, n0 = 32 * nb;
#pragma unroll 8
    for (int i = 0; i < 32; ++i) { const int kk = 2 * i + (lane >> 5); scr[kk * 33 + (lane & 31)] = W[(size_t)(k0 + kk) * N + n0 + (lane & 31)]; }
    LDS_WAIT();
    const int c = lane & 7;
#pragma unroll
    for (int j = 0; j < 4; ++j) { const int n = (lane >> 3) + 8 * j; const LAS float* s = scr + (8 * c) * 33 + n;
        u32x4 o; o.x = pk2(s[0 * 33], s[1 * 33]); o.y = pk2(s[2 * 33], s[3 * 33]); o.z = pk2(s[4 * 33], s[5 * 33]); o.w = pk2(s[6 * 33], s[7 * 33]);
        *(u32x4*)(WT + (size_t)(n0 + n) * K + k0 + 8 * c) = o; }
    LDS_WAIT();
}
__device__ __forceinline__ void rms_row_to_bf16(const float* xrow, const float* g, bf16_t* orow, int lane) {
    const f32x4* xr = (const f32x4*)xrow + lane; const f32x4* gr = (const f32x4*)g + lane;
    f32x4 v[4]; float s = 0.f;
#pragma unroll
    for (int j = 0; j < 4; ++j) { v[j] = xr[64 * j]; s += (v[j].x * v[j].x + v[j].y * v[j].y) + (v[j].z * v[j].z + v[j].w * v[j].w); }
    const float r = rsqrtf(wave_sum(s) * (1.f / 1024.f) + EPS);
    u32x2* o8 = (u32x2*)orow + lane;
#pragma unroll
    for (int j = 0; j < 4; ++j) { const f32x4 gv = gr[64 * j]; u32x2 w; w.x = pk2(v[j].x * r * gv.x, v[j].y * r * gv.y); w.y = pk2(v[j].z * r * gv.z, v[j].w * r * gv.w); o8[64 * j] = w; }
}

template <int L> __device__ __forceinline__ void win_copy(const float* src, float* dst, size_t gtid, size_t nth) {
    constexpr size_t per = (size_t)(L - DS) * 256;
    const f32x4* s4 = (const f32x4*)src; f32x4* d4 = (f32x4*)dst;
    for (size_t i = gtid; i < per * DB; i += nth) { const size_t b = i / per, rem = i - b * per;
        const f32x4 v = __builtin_nontemporal_load(s4 + b * (size_t)L * 256 + 1024 + rem);
        __builtin_nontemporal_store(v, d4 + b * (size_t)L * 256 + rem); }
}

__device__ __forceinline__ void phase_prep(const Args& a, LAS unsigned char* lds) {
    const int tid = threadIdx.x, lane = tid & 63, wave = tid >> 6;
    const int gw = blockIdx.x * 8 + wave, NGW = gridDim.x * 8;
    const size_t gtid = (size_t)blockIdx.x * 512 + tid, nth = (size_t)gridDim.x * 512;
    unsigned char* ws = a.ws;
    { float* sq = (float*)(ws + WS_SUMSQ); for (size_t i = gtid; i < 3 * MPAD; i += nth) sq[i] = 0.f; }
    LAS float* scr = (LAS float*)(lds + wave * 16384);
    constexpr int I_INA = 16 * 160, I_SQ = 16 * 32, I_GLU = 8 * 16, I_UP = 16 * 176, I_DN = 44 * 32;
    constexpr int NITEMS = I_INA + I_SQ + I_GLU + 4 * I_SQ + 2 * I_UP + 2 * I_DN;
    for (int it = gw; it < NITEMS; it += NGW) {
        int r = it;
        if (r < I_INA) { transpose_item(a.in[11], 1024, NIN_A, (bf16_t*)(ws + WS_WINA), scr, r, lane); continue; } r -= I_INA;
        if (r < I_SQ) { transpose_item(a.in[14], 1024, 1024, (bf16_t*)(ws + WS_WINB), scr, r, lane); continue; } r -= I_SQ;
        if (r < I_GLU) { transpose_item(a.in[23], 512, 512, (bf16_t*)(ws + WS_WGLU), scr, r, lane); continue; } r -= I_GLU;
        if (r < 2 * I_SQ) { const int i = r / I_SQ; transpose_item(a.in[26] + (size_t)i * DM * DM, 1024, 1024, (bf16_t*)(ws + WS_WMKV) + (size_t)i * DM * DM, scr, r - i * I_SQ, lane); continue; } r -= 2 * I_SQ;
        if (r < 2 * I_SQ) { const int i = r / I_SQ; transpose_item(a.in[29] + (size_t)i * DM * DM, 1024, 1024, (bf16_t*)(ws + WS_WOUT) + (size_t)i * DM * DM, scr, r - i * I_SQ, lane); continue; } r -= 2 * I_SQ;
        if (r < 2 * I_UP) { const int i = r / I_UP; transpose_item(a.in[30] + (size_t)i * DM * NUP, 1024, NUP, (bf16_t*)(ws + WS_WUP) + (size_t)i * DM * NUP, scr, r - i * I_UP, lane); continue; } r -= 2 * I_UP;
        { const int i = r / I_DN; transpose_item(a.in[33] + (size_t)i * DFF * DM, DFF, 1024, (bf16_t*)(ws + WS_WDN) + (size_t)i * DFF * DM, scr, r - i * I_DN, lane); }
    }
    bf16_t* HB = (bf16_t*)(ws + WS_HB);
    for (int m = gw; m < MPAD; m += NGW) {
        if (m < MP) rms_row_to_bf16(a.in[0] + (size_t)m * DM, a.in[9], HB + (size_t)m * DM, lane);
        else if (m < MT) rms_row_to_bf16(a.in[1] + (size_t)(m - MP) * DM, a.in[9], HB + (size_t)m * DM, lane);
        else { u32x4 z = {0u, 0u, 0u, 0u}; u32x4* o = (u32x4*)(HB + (size_t)m * DM); o[lane] = z; o[lane + 64] = z; }
    }
    for (int m = gw; m < 2048; m += NGW) { const int i = m >> 10, r = m & 1023;
        rms_row_to_bf16(a.in[8] + (size_t)r * DM, a.in[25] + i * DM, (bf16_t*)(ws + WS_MEMN) + (size_t)m * DM, lane); }
    { const f32x4* s4 = (const f32x4*)a.in[5]; u32x4* d = (u32x4*)(ws + WS_SMKV); constexpr size_t n8 = (size_t)2 * DB * 256 * 1024 / 8;
      for (size_t i = gtid; i < n8; i += nth) { const f32x4 v0 = s4[2 * i], v1 = s4[2 * i + 1]; u32x4 w; w.x = pk2(v0.x, v0.y); w.y = pk2(v0.z, v0.w); w.z = pk2(v1.x, v1.y); w.w = pk2(v1.z, v1.w); d[i] = w; } }
    win_copy<128>(a.in[2], a.out + O_SW0, gtid, nth);
    win_copy<512>(a.in[3], a.out + O_SW1, gtid, nth);
    win_copy<2048>(a.in[4], a.out + O_SW2, gtid, nth);
}

__device__ __constant__ double ROPE_INV_TURNS[16] = {0.15915494309189535, 0.07008652158779852, 0.030863763404701233, 0.013591370636193905, 0.005985185712713706, 0.002635675898667413, 0.001160663641240061, 0.0005111175045375439,
    0.00022507907903927658, 9.91173093690194e-05, 4.364795279280288e-05, 1.922110068494486e-05, 8.464330808241401e-06, 3.7274086019153524e-06, 1.641426262795035e-06, 7.228293068832867e-07};

__device__ __forceinline__ void p2_row(const Args& a, int row, int lane) {
    bf16_t* pr = (bf16_t*)(a.ws + WS_PROJ) + (size_t)row * NIN_A;
    const bool samp = row >= MP;
    int b, pos;
    if (!samp) { b = row >> 12; pos = row & 4095; } else { b = (row - MP) >> 2; pos = PAST + ((row - MP) & 3); }
    float c0, s0, c1, s1;
    { const int j0 = (2 * lane) & 15;
      double t0 = (double)pos * ROPE_INV_TURNS[j0], t1 = (double)pos * ROPE_INV_TURNS[j0 + 1];
      t0 -= floor(t0); t1 -= floor(t1);
      c0 = __builtin_amdgcn_cosf((float)t0); s0 = __builtin_amdgcn_sinf((float)t0); c1 = __builtin_amdgcn_cosf((float)t1); s1 = __builtin_amdgcn_sinf((float)t1); }
    const float sgn = (lane < 8) ? -1.f : 1.f;
#pragma unroll 1
    for (int idx = 0; idx < 24; ++idx) {
        const int which = idx / 12, g = (idx % 12) >> 2, h = idx & 3;
        const int col = which * 1536 + g * 512 + h * 128 + 2 * lane;
        const unsigned w = *(const unsigned*)(pr + col);
        float x0 = bflo(w), x1 = bfhi(w);
        const float r = rsqrtf(wave_sum(x0 * x0 + x1 * x1) * (1.f / 128.f) + EPS);
        const float* gain = (which == 0 ? a.in[12] : a.in[13]) + g * 128 + 2 * lane;
        x0 *= r * gain[0]; x1 *= r * gain[1];
        const float p0 = __shfl_xor(x0, 8), p1 = __shfl_xor(x1, 8);
        if (lane < 16) { x0 = x0 * c0 + sgn * p0 * s0; x1 = x1 * c1 + sgn * p1 * s1; }
        if (which == 0) { *(unsigned*)(pr + col) = pk2(x0 * QSCALE, x1 * QSCALE); }
        else {
            *(unsigned*)(pr + col) = pk2(x0, x1);
            const int W = 128 << (2 * g);
            const size_t obase = g == 0 ? (samp ? O_SW0 : O_PW0) : g == 1 ? (samp ? O_SW1 : O_PW1) : (samp ? O_SW2 : O_PW2);
            int slot = samp ? (W - DS + (pos - PAST)) : (pos - (SEQ - W));
            if (slot >= 0) { f32x2 o = {x0, x1}; *(f32x2*)(a.out + obase + (((size_t)b * W + slot) * 2 + 0) * 512 + h * 128 + 2 * lane) = o; }
        }
    }
#pragma unroll 1
    for (int idx = 0; idx < 12; ++idx) {
        const int g = idx >> 2, h = idx & 3;
        const int W = 128 << (2 * g);
        const size_t obase = g == 0 ? (samp ? O_SW0 : O_PW0) : g == 1 ? (samp ? O_SW1 : O_PW1) : (samp ? O_SW2 : O_PW2);
        const int slot = samp ? (W - DS + (pos - PAST)) : (pos - (SEQ - W));
        if (slot >= 0) { const unsigned w = *(const unsigned*)(pr + 3072 + g * 512 + h * 128 + 2 * lane); f32x2 o = {bflo(w), bfhi(w)};
            *(f32x2*)(a.out + obase + (((size_t)b * W + slot) * 2 + 1) * 512 + h * 128 + 2 * lane) = o; }
    }
}
__device__ __forceinline__ void p2_memrow(const Args& a, int m, int lane) {
    const int i = m >> 10;
    const bf16_t* src = (const bf16_t*)(a.ws + WS_MKVR) + (size_t)m * DM; bf16_t* dst = (bf16_t*)(a.ws + WS_MKV) + (size_t)m * DM;
    float* out = a.out + O_PMEM + (size_t)m * DM;
#pragma unroll 1
    for (int h = 0; h < 4; ++h) {
        const unsigned w = *(const unsigned*)(src + h * 128 + 2 * lane);
        float x0 = bflo(w), x1 = bfhi(w);
        const float r = rsqrtf(wave_sum(x0 * x0 + x1 * x1) * (1.f / 128.f) + EPS);
        const float* gain = a.in[28] + i * 128 + 2 * lane;
        x0 *= r * gain[0]; x1 *= r * gain[1];
        *(unsigned*)(dst + h * 128 + 2 * lane) = pk2(x0, x1);
        f32x2 o = {x0, x1}; *(f32x2*)(out + h * 128 + 2 * lane) = o;
        const unsigned wv = *(const unsigned*)(src + 512 + h * 128 + 2 * lane);
        *(unsigned*)(dst + 512 + h * 128 + 2 * lane) = wv;
        f32x2 ov = {bflo(wv), bfhi(wv)}; *(f32x2*)(out + 512 + h * 128 + 2 * lane) = ov;
    }
}

struct AttnDesc {
    const bf16_t* Q; long qs;
    const bf16_t* K; const bf16_t* V; long ks;
    int jmin; int band;
    const float* gq;
    bf16_t* O; long os; float* L2; long ls; int nvalid;
};
__device__ __forceinline__ void attn_item(const AttnDesc& d, LAS unsigned char* lds) {
    const int tid = threadIdx.x, lane = tid & 63, w = tid >> 6, l16 = lane & 15, quad = lane >> 4;
    LAS unsigned char* Kl = lds; LAS unsigned char* Vl = lds + 65536;
    {
        u32x4 kr[8], vr[8];
#pragma unroll
        for (int it = 0; it < 8; ++it) { const int id = it * 512 + tid, key = id >> 4, ch = id & 15;
            if (key >= d.jmin) { kr[it] = *(const u32x4*)(d.K + (long)key * d.ks + ch * 8); vr[it] = *(const u32x4*)(d.V + (long)key * d.ks + ch * 8); }
            else { kr[it] = (u32x4){0u, 0u, 0u, 0u}; vr[it] = (u32x4){0u, 0u, 0u, 0u}; } }
#pragma unroll
        for (int it = 0; it < 8; ++it) { const int id = it * 512 + tid, key = id >> 4, ch = id & 15;
            *(LAS u32x4*)(Kl + key * 256 + ((ch ^ (key & 15)) << 4)) = kr[it];
            *(LAS u32x4*)(Vl + key * 256 + ((((ch >> 1) ^ (key & 7)) << 5) | ((ch & 1) << 4))) = vr[it]; }
    }
    bf16x8 qf[4];
    {
        const bf16_t* qp = d.Q + (long)(16 * w + l16) * d.qs + quad * 8;
        u32x4 qr[4];
#pragma unroll
        for (int ks = 0; ks < 4; ++ks) qr[ks] = *(const u32x4*)(qp + ks * 32);
        if (d.gq) {
            float ss = 0.f;
#pragma unroll
            for (int ks = 0; ks < 4; ++ks) { const float x[8] = {bflo(qr[ks].x), bfhi(qr[ks].x), bflo(qr[ks].y), bfhi(qr[ks].y), bflo(qr[ks].z), bfhi(qr[ks].z), bflo(qr[ks].w), bfhi(qr[ks].w)};
#pragma unroll
                for (int e = 0; e < 8; ++e) ss += x[e] * x[e]; }
            ss += __shfl_xor(ss, 16); ss += __shfl_xor(ss, 32);
            const float r = rsqrtf(ss * (1.f / 128.f) + EPS) * QSCALE;
#pragma unroll
            for (int ks = 0; ks < 4; ++ks) { const f32x4 g0 = *(const f32x4*)(d.gq + ks * 32 + quad * 8), g1 = *(const f32x4*)(d.gq + ks * 32 + quad * 8 + 4);
                qr[ks].x = pk2(bflo(qr[ks].x) * r * g0[0], bfhi(qr[ks].x) * r * g0[1]); qr[ks].y = pk2(bflo(qr[ks].y) * r * g0[2], bfhi(qr[ks].y) * r * g0[3]);
                qr[ks].z = pk2(bflo(qr[ks].z) * r * g1[0], bfhi(qr[ks].z) * r * g1[1]); qr[ks].w = pk2(bflo(qr[ks].w) * r * g1[2], bfhi(qr[ks].w) * r * g1[3]); }
        }
#pragma unroll
        for (int ks = 0; ks < 4; ++ks) qf[ks] = __builtin_bit_cast(bf16x8, qr[ks]);
    }
    __syncthreads();
    f32x4 s[16];
#pragma unroll
    for (int n = 0; n < 16; ++n) {
        s[n] = (f32x4){0.f, 0.f, 0.f, 0.f};
#pragma unroll
        for (int ks = 0; ks < 4; ++ks) {
            const bf16x8 kf = *(const LAS bf16x8*)(Kl + (16 * n + l16) * 256 + ((((ks << 2) | quad) ^ l16) << 4));
            s[n] = __builtin_amdgcn_mfma_f32_16x16x32_bf16(kf, qf[ks], s[n], 0, 0, 0);
        }
    }
    const int qi = 16 * w + l16;
    float mx = NEGBIG;
#pragma unroll
    for (int n = 0; n < 16; ++n)
#pragma unroll
        for (int j = 0; j < 4; ++j) { const int jj = 16 * n + 4 * quad + j;
            if (d.band) { const bool ok = (jj >= qi) && (jj <= qi + 128) && (jj >= d.jmin); s[n][j] = ok ? s[n][j] : NEGBIG; }
            mx = fmaxf(mx, s[n][j]); }
    mx = fmaxf(mx, __shfl_xor(mx, 16)); mx = fmaxf(mx, __shfl_xor(mx, 32));
    float lsum = 0.f;
#pragma unroll
    for (int n = 0; n < 16; ++n)
#pragma unroll
        for (int j = 0; j < 4; ++j) { const float p = __builtin_amdgcn_exp2f(s[n][j] - mx); s[n][j] = p; lsum += p; }
    lsum += __shfl_xor(lsum, 16); lsum += __shfl_xor(lsum, 32);
    bf16x8 pf[8];
#pragma unroll
    for (int k2 = 0; k2 < 8; ++k2) { u32x4 t; t.x = pk2(s[2 * k2][0], s[2 * k2][1]); t.y = pk2(s[2 * k2][2], s[2 * k2][3]); t.z = pk2(s[2 * k2 + 1][0], s[2 * k2 + 1][1]); t.w = pk2(s[2 * k2 + 1][2], s[2 * k2 + 1][3]);
        pf[k2] = __builtin_bit_cast(bf16x8, t); }
    f32x4 o[8];
#pragma unroll
    for (int nd = 0; nd < 8; ++nd) o[nd] = (f32x4){0.f, 0.f, 0.f, 0.f};
    const int kx = ((quad & 1) << 2) | (l16 >> 2);
    const LAS unsigned char* vb = Vl + (4 * quad + (l16 >> 2)) * 256 + 8 * (l16 & 3);
#pragma unroll
    for (int k2 = 0; k2 < 8; ++k2)
#pragma unroll
        for (int nd = 0; nd < 8; ++nd) {
            const LAS unsigned char* p0 = vb + k2 * 32 * 256 + ((nd ^ kx) << 5);
            const s16x4 lo = __builtin_bit_cast(s16x4, __builtin_amdgcn_ds_read_tr16_b64_v4i16((LAS s16x4*)p0));
            const s16x4 hi = __builtin_bit_cast(s16x4, __builtin_amdgcn_ds_read_tr16_b64_v4i16((LAS s16x4*)(p0 + 16 * 256)));
            const bf16x8 vf = {lo[0], lo[1], lo[2], lo[3], hi[0], hi[1], hi[2], hi[3]};
            o[nd] = __builtin_amdgcn_mfma_f32_16x16x32_bf16(vf, pf[k2], o[nd], 0, 0, 0);
        }
    if (qi < d.nvalid) {
        const float inv = 1.f / lsum;
        bf16_t* op = d.O + (long)qi * d.os + 4 * quad;
#pragma unroll
        for (int nd = 0; nd < 8; ++nd) { u32x2 t; t.x = pk2(o[nd][0] * inv, o[nd][1] * inv); t.y = pk2(o[nd][2] * inv, o[nd][3] * inv); *(u32x2*)(op + 16 * nd) = t; }
        if (d.L2 && quad == 0) d.L2[(long)qi * d.ls] = mx + __builtin_amdgcn_logf(lsum);
    }
    __syncthreads();
}

__device__ __forceinline__ void dil_prompt_item(const Args& a, int it, LAS unsigned char* lds) {
    const int idx32 = it & 31, h = (it >> 5) & 3, g = (it >> 7) % 3, b = it / 384;
    const int rs = 2 * g, r = 1 << rs, nblk = 32 >> rs;
    const int c = idx32 / nblk, blk = idx32 % nblk;
    const bf16_t* P = (const bf16_t*)(a.ws + WS_PROJ);
    AttnDesc d;
    const long row_q0 = (long)b * SEQ + (long)blk * 128 * r + c;
    d.Q = P + row_q0 * NIN_A + g * 512 + h * 128; d.qs = (long)r * NIN_A;
    const long row_k0 = row_q0 - (long)128 * r;
    d.K = P + row_k0 * NIN_A + 1536 + g * 512 + h * 128; d.V = P + row_k0 * NIN_A + 3072 + g * 512 + h * 128; d.ks = (long)r * NIN_A;
    d.jmin = blk == 0 ? 128 : 0; d.band = 1; d.gq = nullptr;
    d.O = (bf16_t*)(a.ws + WS_OG) + (size_t)g * MT * 512 + row_q0 * 512 + h * 128; d.os = (long)r * 512;
    d.L2 = (float*)(a.ws + WS_L2G) + (size_t)g * MT * 4 + row_q0 * 4 + h; d.ls = (long)r * 4; d.nvalid = 128;
    attn_item(d, lds);
}
__device__ __forceinline__ void cross_item(const Args& a, int layer, int it, LAS unsigned char* lds) {
    AttnDesc d; d.jmin = 0; d.band = 0; d.gq = a.in[27] + layer * 128; d.L2 = nullptr; d.ls = 0;
    const bf16_t* P = layer == 0 ? (const bf16_t*)(a.ws + WS_PROJ) : (const bf16_t*)(a.ws + WS_PROJ1);
    const long pitch = layer == 0 ? NIN_A : DM; const int qcol = layer == 0 ? 4608 : 512;
    bf16_t* MG = (bf16_t*)(a.ws + WS_MERGED);
    d.qs = pitch; d.ks = DM; d.os = DM;
    if (it < 512) { const int h = it & 3, blk = (it >> 2) & 31, b = it >> 7; const long row0 = (long)b * SEQ + blk * 128;
        d.Q = P + row0 * pitch + qcol + h * 128;
        const bf16_t* kv = (const bf16_t*)(a.ws + WS_MKV) + ((size_t)layer * 1024 + b * 256) * DM;
        d.K = kv + h * 128; d.V = kv + 512 + h * 128; d.O = MG + row0 * DM + 512 + h * 128; d.nvalid = 128; }
    else { const int h = it & 3, b = (it - 512) >> 2; const long row0 = MP + b * DS;
        d.Q = P + row0 * pitch + qcol + h * 128;
        const bf16_t* kv = (const bf16_t*)(a.ws + WS_SMKV) + ((size_t)layer * DB + b) * 256 * DM;
        d.K = kv + h * 128; d.V = kv + 512 + h * 128; d.O = MG + row0 * DM + 512 + h * 128; d.nvalid = DS; }
    attn_item(d, lds);
}

__device__ __forceinline__ void sample_dil_item(const Args& a, int wi, LAS float* wl, int lane) {
    const int h = wi & 3, g = (wi >> 2) % 3, bt = wi / 12, b = bt >> 2, t = bt & 3;
    const int r = 1 << (2 * g), Lb = 128 * r;
    const float* cache = g == 0 ? a.in[2] : g == 1 ? a.in[3] : a.in[4];
    const bf16_t* P = (const bf16_t*)(a.ws + WS_PROJ);
    const long row = MP + b * DS + t;
    { const unsigned w = *(const unsigned*)(P + row * NIN_A + g * 512 + h * 128 + 2 * lane); wl[2 * lane] = bflo(w); wl[2 * lane + 1] = bfhi(w); }
    LDS_WAIT();
    float sc[3];
#pragma unroll
    for (int kk = 0; kk < 3; ++kk) {
        const int j = kk < 2 ? lane + 64 * kk : 128; const bool active = kk < 2 || lane == 0;
        const int idx = Lb + t - r * j;
        float dot = 0.f;
        if (active) {
            if (idx >= Lb) { const bf16_t* kp = P + (long)(MP + b * DS + (idx - Lb)) * NIN_A + 1536 + g * 512 + h * 128;
#pragma unroll 4
                for (int c8 = 0; c8 < 16; ++c8) { const u32x4 kv = *(const u32x4*)(kp + c8 * 8); const f32x4 q0 = *(const LAS f32x4*)(wl + c8 * 8), q1 = *(const LAS f32x4*)(wl + c8 * 8 + 4);
                    dot += bflo(kv.x) * q0[0] + bfhi(kv.x) * q0[1] + bflo(kv.y) * q0[2] + bfhi(kv.y) * q0[3] + bflo(kv.z) * q1[0] + bfhi(kv.z) * q1[1] + bflo(kv.w) * q1[2] + bfhi(kv.w) * q1[3]; } }
            else { const float* kp = cache + (((size_t)b * Lb + idx) * 2 + 0) * 512 + h * 128;
#pragma unroll 8
                for (int c4 = 0; c4 < 32; ++c4) { const f32x4 kv = *(const f32x4*)(kp + c4 * 4); const f32x4 q0 = *(const LAS f32x4*)(wl + c4 * 4);
                    dot += kv[0] * q0[0] + kv[1] * q0[1] + kv[2] * q0[2] + kv[3] * q0[3]; } }
        }
        sc[kk] = active ? dot : NEGBIG;
    }
    const float mx = wave_max(fmaxf(fmaxf(sc[0], sc[1]), sc[2]));
    float ps[3]; float lsum = 0.f;
#pragma unroll
    for (int kk = 0; kk < 3; ++kk) { ps[kk] = __builtin_amdgcn_exp2f(sc[kk] - mx); lsum += ps[kk]; }
    lsum = wave_sum(lsum);
    wl[128 + lane] = ps[0]; wl[192 + lane] = ps[1]; if (lane == 0) wl[256] = ps[2];
    LDS_WAIT();
    float o0 = 0.f, o1 = 0.f;
#pragma unroll 4
    for (int j = 0; j <= 128; ++j) {
        const int idx = Lb + t - r * j; const float pj = wl[128 + j];
        if (idx >= Lb) { const unsigned w = *(const unsigned*)(P + (long)(MP + b * DS + (idx - Lb)) * NIN_A + 3072 + g * 512 + h * 128 + 2 * lane); o0 += pj * bflo(w); o1 += pj * bfhi(w); }
        else { const f32x2 v = *(const f32x2*)(cache + (((size_t)b * Lb + idx) * 2 + 1) * 512 + h * 128 + 2 * lane); o0 += pj * v[0]; o1 += pj * v[1]; }
    }
    const float inv = 1.f / lsum;
    *(unsigned*)((bf16_t*)(a.ws + WS_OG) + (size_t)g * MT * 512 + row * 512 + h * 128 + 2 * lane) = pk2(o0 * inv, o1 * inv);
    if (lane == 0) ((float*)(a.ws + WS_L2G))[(size_t)g * MT * 4 + row * 4 + h] = mx + __builtin_amdgcn_logf(lsum);
    LDS_WAIT();
}

__device__ __forceinline__ void phase_attn0(const Args& a, LAS unsigned char* lds) {
    const int G = gridDim.x;
    constexpr int NI = 1536 + 640;
    for (int it = blockIdx.x; it < NI; it += G) { if (it < 1536) dil_prompt_item(a, it, lds); else cross_item(a, 0, it - 1536, lds); }
    const int rem = NI % G;
    const int first = rem, nlight = G - rem;
    if ((int)blockIdx.x >= first) {
        const int wave = threadIdx.x >> 6, lane = threadIdx.x & 63;
        LAS float* wl = (LAS float*)(lds + wave * 2048);
        for (int wi = ((int)blockIdx.x - first) * 8 + wave; wi < DB * DS * 12; wi += nlight * 8) sample_dil_item(a, wi, wl, lane);
    }
}
__device__ __forceinline__ void phase_combine(const Args& a) {
    const size_t gtid = (size_t)blockIdx.x * 512 + threadIdx.x, nth = (size_t)gridDim.x * 512;
    const float* L2 = (const float*)(a.ws + WS_L2G); const bf16_t* OG = (const bf16_t*)(a.ws + WS_OG); bf16_t* MG = (bf16_t*)(a.ws + WS_MERGED);
    for (size_t it = gtid; it < (size_t)MT * 64; it += nth) { const size_t row = it >> 6; const int ch = (int)(it & 63), h = ch >> 4;
        const float l0 = L2[row * 4 + h], l1 = L2[(size_t)MT * 4 + row * 4 + h], l2 = L2[(size_t)2 * MT * 4 + row * 4 + h];
        const float mx = fmaxf(l0, fmaxf(l1, l2));
        float w0 = __builtin_amdgcn_exp2f(l0 - mx), w1 = __builtin_amdgcn_exp2f(l1 - mx), w2 = __builtin_amdgcn_exp2f(l2 - mx);
        const float inv = 1.f / (w0 + w1 + w2); w0 *= inv; w1 *= inv; w2 *= inv;
        const u32x4 a0 = *(const u32x4*)(OG + row * 512 + ch * 8), a1 = *(const u32x4*)(OG + (size_t)MT * 512 + row * 512 + ch * 8), a2 = *(const u32x4*)(OG + (size_t)2 * MT * 512 + row * 512 + ch * 8);
        u32x4 o;
        o.x = pk2(w0 * bflo(a0.x) + w1 * bflo(a1.x) + w2 * bflo(a2.x), w0 * bfhi(a0.x) + w1 * bfhi(a1.x) + w2 * bfhi(a2.x));
        o.y = pk2(w0 * bflo(a0.y) + w1 * bflo(a1.y) + w2 * bflo(a2.y), w0 * bfhi(a0.y) + w1 * bfhi(a1.y) + w2 * bfhi(a2.y));
        o.z = pk2(w0 * bflo(a0.z) + w1 * bflo(a1.z) + w2 * bflo(a2.z), w0 * bfhi(a0.z) + w1 * bfhi(a1.z) + w2 * bfhi(a2.z));
        o.w = pk2(w0 * bflo(a0.w) + w1 * bflo(a1.w) + w2 * bflo(a2.w), w0 * bfhi(a0.w) + w1 * bfhi(a1.w) + w2 * bfhi(a2.w));
        *(u32x4*)(MG + row * DM + ch * 8) = o; }
}

__device__ __forceinline__ void unpack8(const u32x4 w, float (&x)[8]) { x[0] = bflo(w.x); x[1] = bfhi(w.x); x[2] = bflo(w.y); x[3] = bfhi(w.y); x[4] = bflo(w.z); x[5] = bfhi(w.z); x[6] = bflo(w.w); x[7] = bfhi(w.w); }
__device__ __forceinline__ void load8f(const float* p, float (&x)[8]) { const f32x4 a = *(const f32x4*)p, b = *(const f32x4*)(p + 4); x[0] = a[0]; x[1] = a[1]; x[2] = a[2]; x[3] = a[3]; x[4] = b[0]; x[5] = b[1]; x[6] = b[2]; x[7] = b[3]; }
__device__ __forceinline__ void phase_conv(const Args& a, int layer) {
    const size_t gtid = (size_t)blockIdx.x * 512 + threadIdx.x, nth = (size_t)gridDim.x * 512;
    const bf16_t* UP = (const bf16_t*)(a.ws + WS_PROJ); bf16_t* ACT = (bf16_t*)(a.ws + WS_ACT);
    const float* cw = a.in[31] + (size_t)layer * 3 * NUP; const float* cb = a.in[32] + (size_t)layer * NUP;
    constexpr int NCC = DFF / 8;
    for (size_t it = gtid; it < (size_t)(2048 + DB) * NCC; it += nth) {
        const int cc = (int)(it % NCC), rg = (int)(it / NCC), col = cc * 8;
        float wa[3][8], wb[3][8], ba[8], bb[8];
#pragma unroll
        for (int j = 0; j < 3; ++j) { load8f(cw + j * NUP + col, wa[j]); load8f(cw + j * NUP + DFF + col, wb[j]); }
        load8f(cb + col, ba); load8f(cb + DFF + col, bb);
        float a2[8], a1[8], b2[8], b1[8];
        int row0, nrows;
        if (rg < 2048) { row0 = rg * 8; nrows = 8;
            if ((row0 & 4095) == 0) {
#pragma unroll
                for (int e = 0; e < 8; ++e) { a2[e] = 0.f; a1[e] = 0.f; b2[e] = 0.f; b1[e] = 0.f; } }
            else { unpack8(*(const u32x4*)(UP + (size_t)(row0 - 2) * NUP + col), a2); unpack8(*(const u32x4*)(UP + (size_t)(row0 - 1) * NUP + col), a1);
                   unpack8(*(const u32x4*)(UP + (size_t)(row0 - 2) * NUP + DFF + col), b2); unpack8(*(const u32x4*)(UP + (size_t)(row0 - 1) * NUP + DFF + col), b1); } }
        else { const int b = rg - 2048; row0 = MP + b * DS; nrows = DS;
            const float* st = a.in[7] + ((size_t)layer * DB + b) * 2 * NUP;
            load8f(st + col, a2); load8f(st + NUP + col, a1); load8f(st + DFF + col, b2); load8f(st + NUP + DFF + col, b1); }
        for (int r = 0; r < nrows; ++r) {
            float ac[8], bc[8];
            unpack8(*(const u32x4*)(UP + (size_t)(row0 + r) * NUP + col), ac); unpack8(*(const u32x4*)(UP + (size_t)(row0 + r) * NUP + DFF + col), bc);
            float o[8];
#pragma unroll
            for (int e = 0; e < 8; ++e) { const float A = ba[e] + wa[0][e] * a2[e] + wa[1][e] * a1[e] + wa[2][e] * ac[e]; const float B = bb[e] + wb[0][e] * b2[e] + wb[1][e] * b1[e] + wb[2][e] * bc[e];
                o[e] = A / (1.f + __expf(-A)) * B; a2[e] = a1[e]; a1[e] = ac[e]; b2[e] = b1[e]; b1[e] = bc[e]; }
            u32x4 w; w.x = pk2(o[0], o[1]); w.y = pk2(o[2], o[3]); w.z = pk2(o[4], o[5]); w.w = pk2(o[6], o[7]);
            *(u32x4*)(ACT + (size_t)(row0 + r) * DFF + col) = w;
        }
    }
    constexpr int NC8 = NUP / 8;
    for (size_t it = gtid; it < (size_t)(NB + DB) * 2 * NC8; it += nth) {
        const int c8 = (int)(it % NC8), rr = (int)((it / NC8) & 1), sb = (int)(it / (2 * NC8));
        size_t srow; float* dst;
        if (sb < NB) { srow = (size_t)sb * SEQ + SEQ - 2 + rr; dst = a.out + O_PCONV + (((size_t)layer * NB + sb) * 2 + rr) * NUP + c8 * 8; }
        else { const int b = sb - NB; srow = (size_t)MP + b * DS + 2 + rr; dst = a.out + O_SCONV + (((size_t)layer * DB + b) * 2 + rr) * NUP + c8 * 8; }
        float x[8]; unpack8(*(const u32x4*)(UP + srow * NUP + c8 * 8), x);
        *(f32x4*)dst = (f32x4){x[0], x[1], x[2], x[3]}; *(f32x4*)(dst + 4) = (f32x4){x[4], x[5], x[6], x[7]};
    }
}

struct S5C { float lbr, lbi; float bbr[16], bbi[16]; };
__device__ __forceinline__ void s5_consts(const Args& a, int G, int lane, S5C& c) {
    const float are = a.in[15][G * 64 + lane], aim = a.in[16][G * 64 + lane], dt = __expf(a.in[17][G]);
    const float mag = __expf(are * dt);
    float turns = aim * dt * 0.15915494309189535f; turns -= rintf(turns);
    c.lbr = mag * __builtin_amdgcn_cosf(turns); c.lbi = mag * __builtin_amdgcn_sinf(turns);
    const float den = are * are + aim * aim, xr = c.lbr - 1.f, yi = c.lbi;
    const float fre = (xr * are + yi * aim) / den, fim = (yi * are - xr * aim) / den;
    const float* br = a.in[18] + (size_t)(G * 64 + lane) * 16; const float* bi = a.in[19] + (size_t)(G * 64 + lane) * 16;
#pragma unroll
    for (int q = 0; q < 4; ++q) { const f32x4 r4 = *(const f32x4*)(br + 4 * q), i4 = *(const f32x4*)(bi + 4 * q);
#pragma unroll
        for (int e = 0; e < 4; ++e) { c.bbr[4 * q + e] = fre * r4[e] - fim * i4[e]; c.bbi[4 * q + e] = fre * i4[e] + fim * r4[e]; } }
}
__device__ __forceinline__ void s5_step(const S5C& c, const bf16_t* up, float& sr, float& si) {
    const u32x4 w0 = *(const u32x4*)up, w1 = *(const u32x4*)(up + 8);
    float u[16]; { float t0[8], t1[8]; unpack8(w0, t0); unpack8(w1, t1);
#pragma unroll
        for (int e = 0; e < 8; ++e) { u[e] = t0[e]; u[8 + e] = t1[e]; } }
    float br = 0.f, bi = 0.f;
#pragma unroll
    for (int e = 0; e < 16; ++e) { br += c.bbr[e] * u[e]; bi += c.bbi[e] * u[e]; }
    const float nr = c.lbr * sr - c.lbi * si + br, ni = c.lbr * si + c.lbi * sr + bi;
    sr = nr; si = ni;
}
__device__ __forceinline__ void phase_s5_pass1(const Args& a) {
    const int lane = threadIdx.x & 63, wave = threadIdx.x >> 6;
    const int gw = blockIdx.x * 8 + wave, NGW = gridDim.x * 8;
    const bf16_t* P1 = (const bf16_t*)(a.ws + WS_PROJ1); f32x2* E = (f32x2*)(a.ws + WS_E);
    for (int wi = gw; wi < NB * 63 * 32; wi += NGW) {
        const int G = wi & 31, ch = (wi >> 5) % 63, b = (wi >> 5) / 63;
        S5C c; s5_consts(a, G, lane, c);
        float sr = 0.f, si = 0.f;
        const bf16_t* up = P1 + ((size_t)b * SEQ + ch * 64) * DM + G * 16;
#pragma unroll 4
        for (int t = 0; t < 64; ++t) s5_step(c, up + (size_t)t * DM, sr, si);
        E[(((size_t)b * 64 + ch) * 32 + G) * 64 + lane] = (f32x2){sr, si};
    }
}
__device__ __forceinline__ void phase_s5_pass2(const Args& a, LAS unsigned char* lds) {
    const int lane = threadIdx.x & 63, wave = threadIdx.x >> 6, l16 = lane & 15, quad = lane >> 4;
    const int gw = blockIdx.x * 8 + wave, NGW = gridDim.x * 8;
    const bf16_t* P1 = (const bf16_t*)(a.ws + WS_PROJ1); const f32x2* E = (const f32x2*)(a.ws + WS_E); bf16_t* Y = (bf16_t*)(a.ws + WS_Y);
    LAS bf16_t* st = (LAS bf16_t*)(lds + wave * 8192);
    for (int wi = gw; wi < NB * 64 * 32 + DB * 32; wi += NGW) {
        const bool prompt = wi < NB * 64 * 32;
        int G, ch, b; size_t row0;
        if (prompt) { G = wi & 31; ch = (wi >> 5) & 63; b = wi >> 11; row0 = (size_t)b * SEQ + ch * 64; }
        else { const int x = wi - NB * 64 * 32; G = x & 31; b = x >> 5; ch = 0; row0 = (size_t)MP + b * DS; }
        S5C c; s5_consts(a, G, lane, c);
        float sr, si;
        if (prompt) {
            float pr = c.lbr, pi = c.lbi;
#pragma unroll
            for (int q = 0; q < 6; ++q) { const float nr = pr * pr - pi * pi, ni = 2.f * pr * pi; pr = nr; pi = ni; }
            sr = 0.f; si = 0.f;
            for (int j = 0; j < ch; ++j) { const f32x2 e = E[(((size_t)b * 64 + j) * 32 + G) * 64 + lane]; const float nr = pr * sr - pi * si + e[0], ni = pr * si + pi * sr + e[1]; sr = nr; si = ni; }
        } else { sr = a.in[6][(((size_t)b * 2 + 0) * 32 + G) * 64 + lane]; si = a.in[6][(((size_t)b * 2 + 1) * 32 + G) * 64 + lane]; }
        bf16x8 cf[4];
#pragma unroll
        for (int ks = 0; ks < 4; ++ks) { const int k0 = ks * 32 + quad * 8; float v[8];
            if (k0 < 64) load8f(a.in[20] + (size_t)(G * 16 + l16) * 64 + k0, v);
            else { load8f(a.in[21] + (size_t)(G * 16 + l16) * 64 + (k0 - 64), v);
#pragma unroll
                for (int e = 0; e < 8; ++e) v[e] = -v[e]; }
            u32x4 t; t.x = pk2(v[0], v[1]); t.y = pk2(v[2], v[3]); t.z = pk2(v[4], v[5]); t.w = pk2(v[6], v[7]); cf[ks] = __builtin_bit_cast(bf16x8, t); }
        const float dsk = a.in[22][G * 16 + l16];
        const int nsub = prompt ? 4 : 1, nst = prompt ? 16 : DS;
        for (int sub = 0; sub < nsub; ++sub) {
            const size_t rbase = row0 + sub * 16;
#pragma unroll 4
            for (int tl = 0; tl < nst; ++tl) {
                s5_step(c, P1 + (rbase + tl) * DM + G * 16, sr, si);
                st[tl * 136 + lane] = f2bf(sr); st[tl * 136 + 64 + lane] = f2bf(si);
            }
            LDS_WAIT();
            f32x4 acc = {0.f, 0.f, 0.f, 0.f};
#pragma unroll
            for (int ks = 0; ks < 4; ++ks) { const bf16x8 af = *(const LAS bf16x8*)(st + l16 * 136 + ks * 32 + quad * 8);
                acc = __builtin_amdgcn_mfma_f32_16x16x32_bf16(af, cf[ks], acc, 0, 0, 0); }
#pragma unroll
            for (int j = 0; j < 4; ++j) { const int t = quad * 4 + j;
                if (t < nst) { const size_t row = rbase + t;
                    const float uval = bf2f(P1[row * DM + G * 16 + l16]);
                    const float y = acc[j] + dsk * uval;
                    const float z2 = 1.5957691216057308f * (y + 0.044715f * y * y * y);
                    Y[row * 512 + G * 16 + l16] = f2bf(y / (1.f + __expf(-z2))); } }
            LDS_WAIT();
        }
        if (prompt) { if (ch == 63) { a.out[O_PS5 + (((size_t)b * 2 + 0) * 32 + G) * 64 + lane] = sr; a.out[O_PS5 + (((size_t)b * 2 + 1) * 32 + G) * 64 + lane] = si; } }
        else { a.out[O_SS5 + (((size_t)b * 2 + 0) * 32 + G) * 64 + lane] = sr; a.out[O_SS5 + (((size_t)b * 2 + 1) * 32 + G) * 64 + lane] = si; }
    }
}

constexpr int NPHASE = 17;
#define GEMM_CALL(EpiT, gdesc, sched, epi) pg8::gemm_phase<EpiT, pg8::StaticOrder, true, true>(lds, gdesc, sched, epi)

__global__ void __launch_bounds__(512, 2) trunk_fwd(Args a) {
    extern __shared__ __attribute__((aligned(16))) unsigned char lds_raw[];
    LAS unsigned char* lds = (LAS unsigned char*)lds_raw;
    cg::grid_group grid = cg::this_grid();
    const int lo = a.ph_lo, hi = a.ph_hi;
    const int G = gridDim.x, bx = blockIdx.x;
    const int wave = threadIdx.x >> 6, lane = threadIdx.x & 63;
    const int gw = bx * 8 + wave, NGW = G * 8;
    unsigned char* ws = a.ws;
    bf16_t* HB = (bf16_t*)(ws + WS_HB);
    float* SUMSQ = (float*)(ws + WS_SUMSQ);
    float* X = (float*)(ws + WS_X);
#define IN(k) (lo <= (k) && (k) < hi)
#define SEAM(k) do { if (IN(k) && IN((k) + 1)) grid.sync(); } while (0)

    if (IN(0)) { phase_prep(a, lds); __syncthreads(); }
    SEAM(0);
    if (IN(1)) {
        { pg8::Gemm g{HB, (const bf16_t*)(ws + WS_WINA), MPAD, NIN_A, DM}; pg8::StaticOrder S; S.init(MPAD, NIN_A, G, bx);
          EpiStoreBf16 E{(bf16_t*)(ws + WS_PROJ), NIN_A, nullptr}; GEMM_CALL(EpiStoreBf16, g, S, E); }
        for (int i = 0; i < 2; ++i) {
            pg8::Gemm g{(const bf16_t*)(ws + WS_MEMN) + (size_t)i * DM * DM, (const bf16_t*)(ws + WS_WMKV) + (size_t)i * DM * DM, 1024, 1024, DM};
            pg8::StaticOrder S; S.init(1024, 1024, G, (bx + 2 * G - 20 - 16 * i) % G);
            EpiStoreBf16 E{(bf16_t*)(ws + WS_MKVR) + (size_t)i * DM * DM, DM, nullptr}; GEMM_CALL(EpiStoreBf16, g, S, E); }
    }
    SEAM(1);
    if (IN(2)) {
        for (int m = gw; m < MT + 2048; m += NGW) { if (m < MT) p2_row(a, m, lane); else p2_memrow(a, m - MT, lane); }
    }
    SEAM(2);
    if (IN(3)) phase_attn0(a, lds);
    SEAM(3);
    if (IN(4)) phase_combine(a);
    SEAM(4);
    if (IN(5)) {
        pg8::Gemm g{(const bf16_t*)(ws + WS_MERGED), (const bf16_t*)(ws + WS_WOUT), MPAD, DM, DM}; pg8::StaticOrder S; S.init(MPAD, DM, G, bx);
        EpiResidual E{a.in[0], a.in[1], X, X + (size_t)MP * DM, SUMSQ, HB, a.in[10]}; GEMM_CALL(EpiResidual, g, S, E); }
    SEAM(5);
    if (IN(6)) {
        pg8::Gemm g{HB, (const bf16_t*)(ws + WS_WUP), MPAD, NUP, DM}; pg8::StaticOrder S; S.init(MPAD, NUP, G, bx);
        EpiStoreBf16 E{(bf16_t*)(ws + WS_PROJ), NUP, SUMSQ}; GEMM_CALL(EpiStoreBf16, g, S, E); }
    SEAM(6);
    if (IN(7)) phase_conv(a, 0);
    SEAM(7);
    if (IN(8)) {
        pg8::Gemm g{(const bf16_t*)(ws + WS_ACT), (const bf16_t*)(ws + WS_WDN), MPAD, DM, DFF}; pg8::StaticOrder S; S.init(MPAD, DM, G, bx);
        EpiResidual E{X, X + (size_t)MP * DM, X, X + (size_t)MP * DM, SUMSQ + MPAD, HB, a.in[9] + DM}; GEMM_CALL(EpiResidual, g, S, E); }
    SEAM(8);
    if (IN(9)) {
        pg8::Gemm g{HB, (const bf16_t*)(ws + WS_WINB), MPAD, DM, DM}; pg8::StaticOrder S; S.init(MPAD, DM, G, bx);
        EpiStoreBf16 E{(bf16_t*)(ws + WS_PROJ1), DM, SUMSQ + MPAD}; GEMM_CALL(EpiStoreBf16, g, S, E); }
    SEAM(9);
    if (IN(10)) {
        for (int it = bx; it < 640; it += G) cross_item(a, 1, it, lds);
        phase_s5_pass1(a);
    }
    SEAM(10);
    if (IN(11)) { phase_s5_pass2(a, lds); __syncthreads(); }
    SEAM(11);
    if (IN(12)) {
        pg8::Gemm g{(const bf16_t*)(ws + WS_Y), (const bf16_t*)(ws + WS_WGLU), MPAD, 512, 512}; pg8::StaticOrder S; S.init(MPAD, 512, G, bx);
        EpiGlu E{(bf16_t*)(ws + WS_MERGED), DM, (const bf16_t*)(ws + WS_Y), a.in[24]}; GEMM_CALL(EpiGlu, g, S, E); }
    SEAM(12);
    if (IN(13)) {
        pg8::Gemm g{(const bf16_t*)(ws + WS_MERGED), (const bf16_t*)(ws + WS_WOUT) + (size_t)DM * DM, MPAD, DM, DM}; pg8::StaticOrder S; S.init(MPAD, DM, G, bx);
        EpiResidual E{X, X + (size_t)MP * DM, X, X + (size_t)MP * DM, SUMSQ + 2 * MPAD, HB, a.in[10] + DM}; GEMM_CALL(EpiResidual, g, S, E); }
    SEAM(13);
    if (IN(14)) {
        pg8::Gemm g{HB, (const bf16_t*)(ws + WS_WUP) + (size_t)NUP * DM, MPAD, NUP, DM}; pg8::StaticOrder S; S.init(MPAD, NUP, G, bx);
        EpiStoreBf16 E{(bf16_t*)(ws + WS_PROJ), NUP, SUMSQ + 2 * MPAD}; GEMM_CALL(EpiStoreBf16, g, S, E); }
    SEAM(14);
    if (IN(15)) phase_conv(a, 1);
    SEAM(15);
    if (IN(16)) {
        pg8::Gemm g{(const bf16_t*)(ws + WS_ACT), (const bf16_t*)(ws + WS_WDN) + (size_t)DM * DFF, MPAD, DM, DFF}; pg8::StaticOrder S; S.init(MPAD, DM, G, bx);
        EpiResidual E{X, X + (size_t)MP * DM, a.out + O_YP, a.out + O_YS, nullptr, nullptr, nullptr}; GEMM_CALL(EpiResidual, g, S, E); }
#undef IN
#undef SEAM
}

extern "C" void kernel_launch(void* const* d_in, const int* in_sizes, int n_in, void* d_out, int out_size, void* d_ws, size_t ws_size, hipStream_t stream) {
    static int grid = 0;
    if (grid == 0) {
        if (n_in != 34 || (size_t)out_size != O_END || ws_size < WS_END) { fprintf(stderr, "kernel_launch: unexpected shapes (n_in %d, out %d, ws %zu)\n", n_in, out_size, ws_size); grid = -1; return; }
        int dev = 0, cus = 0, per_cu = 0;
        if (hipGetDevice(&dev) != hipSuccess || hipDeviceGetAttribute(&cus, hipDeviceAttributeMultiprocessorCount, dev) != hipSuccess) { grid = -1; return; }
        if (hipFuncSetAttribute((const void*)trunk_fwd, hipFuncAttributeMaxDynamicSharedMemorySize, LDS_BYTES) != hipSuccess) { fprintf(stderr, "kernel_launch: hipFuncSetAttribute failed\n"); grid = -1; return; }
        if (hipOccupancyMaxActiveBlocksPerMultiprocessor(&per_cu, (const void*)trunk_fwd, 512, LDS_BYTES) != hipSuccess || per_cu < 1) { fprintf(stderr, "kernel_launch: occupancy query says %d\n", per_cu); grid = -1; (void)hipGetLastError(); return; }
        grid = cus * per_cu;
    }
    if (grid < 0) return;
    Args a{};
    for (int i = 0; i < 34; ++i) a.in[i] = (const float*)d_in[i];
    a.out = (float*)d_out; a.ws = (unsigned char*)d_ws;
#if MK_N_LAUNCHES == 1
    a.ph_lo = 0; a.ph_hi = NPHASE;
    void* args[] = {&a};
    hipError_t e = hipLaunchCooperativeKernel((const void*)trunk_fwd, dim3(grid), dim3(512), args, LDS_BYTES, stream);
    if (e != hipSuccess) fprintf(stderr, "kernel_launch: cooperative launch failed: %s (grid %d)\n", hipGetErrorString(e), grid);
#else
    for (int p = 0; p < NPHASE; ++p) { a.ph_lo = p; a.ph_hi = p + 1; hipLaunchKernelGGL(trunk_fwd, dim3(grid), dim3(512), LDS_BYTES, stream, a); }
#endif
}
```

```cpp
#include <hip/hip_runtime.h>
#include <hip/hip_cooperative_groups.h>
#include <cstdio>
#include <cstdint>
namespace cg = cooperative_groups;
#ifndef MK_N_LAUNCHES
#define MK_N_LAUNCHES 1
#endif
namespace pg8 {
#define PG8_LAS __attribute__((address_space(3)))
typedef unsigned short bf16_t;
typedef short bf16x8 __attribute__((ext_vector_type(8)));
typedef float f32x4 __attribute__((ext_vector_type(4)));
typedef unsigned u32x4 __attribute__((ext_vector_type(4)));
constexpr int BM = 256, BK = 64, HALF = 128, HTB = HALF * BK * 2  , STAGE_BYTES = 8 * HTB, NXCD = 8, WGM = 8;

__host__ __device__ __forceinline__ int lds_byte(int r, int c) { const int st = (r >> 4) * 2 + (c >> 5), rr = r & 15, cc = c & 31, ob = rr * 64 + cc * 2; return st * 1024 + (ob ^ (((ob >> 9) & 1) << 5)); }
__host__ __device__ __forceinline__ void stage_rc(int b, int& R, int& C) { const int st = b / 1024, sb = b % 1024, swz = sb ^ (((sb >> 9) & 1) << 5); R = (st >> 1) * 16 + swz / 64; C = (st & 1) * 32 + (swz % 64) / 2; }
__host__ __device__ __forceinline__ int perm32(int rho) { const int n = rho >> 4, i = rho & 15; return 8 * (i >> 2) + 4 * n + (i & 3); }

struct Unit { int pm, pn; };
struct Gemm { const bf16_t* A; const bf16_t* Bt; int M, N, K; };

struct StaticOrder {
    int nM, nN, nwg, G, c;
    __host__ __device__ void init(int M, int N, int G_, int c_) { nM = M / BM; nN = N / BM; nwg = nM * nN; G = G_; c = c_; }
    __host__ __device__ bool next(int i, Unit& u) const {
        const long L = (long)i * G + c; if (L >= nwg) return false;
        int wgid = (int)L; { const int q = nwg / NXCD, r = nwg % NXCD, xcd = wgid % NXCD, off = wgid / NXCD; wgid = (xcd < r ? xcd * (q + 1) : r * (q + 1) + (xcd - r) * q) + off; }
        const int nig = WGM * nN, gid = wgid / nig, fm = gid * WGM, gsz = (nM - fm) < WGM ? (nM - fm) : WGM;
        u.pm = fm + ((wgid % nig) % gsz); u.pn = (wgid % nig) / gsz; return true;
    }
    __device__ __forceinline__ void a_ready(const Unit&) const {}
    __device__ __forceinline__ void done(const Unit&) const {}
};

__device__ __forceinline__ unsigned cvt_pk_bf16(float lo, float hi) { typedef float f2_ __attribute__((ext_vector_type(2))); typedef __bf16 b2_ __attribute__((ext_vector_type(2))); f2_ v = {lo, hi}; b2_ b = __builtin_convertvector(v, b2_); return __builtin_bit_cast(unsigned, b); }
template <class Epi, class Sched, bool ALIGN_EPI = false, bool SP2 = false>
__device__ __forceinline__ void gemm_phase(PG8_LAS unsigned char* lds, const Gemm g, const Sched& S, const Epi& E) {
    const int tid = threadIdx.x, wid = __builtin_amdgcn_readfirstlane(tid >> 6), lane = tid & 63, wr = wid >> 2, wc = wid & 3, fr = lane & 15, fq = lane >> 4;
    const int K = g.K, nt = K / BK;
    unsigned voffA[2], voffB[2];
#pragma unroll
    for (int i = 0; i < 2; ++i) { int R, C; stage_rc(tid * 16 + i * 8192, R, C); const int Rb = Epi::PERM ? ((R & ~31) + perm32(R & 31)) : R;
        voffA[i] = (unsigned)(R * K + C) * 2u; voffB[i] = (unsigned)(Rb * K + C) * 2u; }
    const size_t kstep = (size_t)(BK * 2);
    const size_t hstep = (size_t)HALF * K * 2;
    const size_t tstep = 2 * hstep;
    const unsigned ldsw = (unsigned)wid * 1024u;
    const int aoff = lds_byte(wr * 64 + fr, fq * 8), boff = lds_byte(wc * 32 + fr, fq * 8);
#define PG8_SA(b, h) (((b) * 2 + (h)) * HTB)
#define PG8_SB(b, h) ((4 + (b) * 2 + (h)) * HTB)
#define PG8_STAGE(bufoff, gbase, voff) do { _Pragma("unroll") for (int _i = 0; _i < 2; ++_i) \
        __builtin_amdgcn_global_load_lds((const unsigned*)((const char*)(gbase) + (voff)[_i]), (PG8_LAS unsigned*)(lds + (bufoff) + ldsw + _i * 8192), 16, 0, 0); } while (0)
#define PG8_LDA(dst, b, h) do { _Pragma("unroll") for (int m = 0; m < 4; ++m) _Pragma("unroll") for (int k = 0; k < 2; ++k) dst[m][k] = *(const PG8_LAS bf16x8*)(lds + PG8_SA(b, h) + aoff + m * 2048 + k * 1024); } while (0)
#define PG8_LDB(dst, b, h) do { _Pragma("unroll") for (int n = 0; n < 2; ++n) _Pragma("unroll") for (int k = 0; k < 2; ++k) dst[n][k] = *(const PG8_LAS bf16x8*)(lds + PG8_SB(b, h) + boff + n * 2048 + k * 1024); } while (0)
#define PG8_MMA(ai, bj, At, Bt) do { __builtin_amdgcn_s_setprio(1); _Pragma("unroll") for (int m = 0; m < 4; ++m) _Pragma("unroll") for (int n = 0; n < 2; ++n) _Pragma("unroll") for (int k = 0; k < 2; ++k) \
        acc[ai][bj][m][n] = __builtin_amdgcn_mfma_f32_16x16x32_bf16(Bt[n][k], At[m][k], acc[ai][bj][m][n], 0, 0, 0); __builtin_amdgcn_s_setprio(0); } while (0)
#define PG8_WAIT_V(n) asm volatile("s_waitcnt vmcnt(" #n ")" ::: "memory")
#define PG8_WAIT_L(n) asm volatile("s_waitcnt lgkmcnt(" #n ")" ::: "memory")
#define PG8_BAR __builtin_amdgcn_s_barrier()
#define PG8_SCHED __builtin_amdgcn_sched_barrier(0)
    Unit cur, nxt; int ui = 0;
    if (!S.next(0, cur)) return;
    f32x4 acc[2][2][4][2];
#pragma unroll
    for (int a = 0; a < 2; ++a)
#pragma unroll
        for (int b = 0; b < 2; ++b)
#pragma unroll
            for (int m = 0; m < 4; ++m)
#pragma unroll
                for (int n = 0; n < 2; ++n) acc[a][b][m][n] = (f32x4){0.f, 0.f, 0.f, 0.f};
    bf16x8 At[4][2], B0[2][2], B1[2][2];
    const char* cA = (const char*)g.A + (size_t)cur.pm * tstep; const char* cB = (const char*)g.Bt + (size_t)cur.pn * tstep;
    S.a_ready(cur);
    if constexpr (SP2) {
        PG8_STAGE(PG8_SB(0, 0), cB, voffB); PG8_STAGE(PG8_SB(0, 1), cB + hstep, voffB); PG8_STAGE(PG8_SA(0, 0), cA, voffA); PG8_STAGE(PG8_SA(0, 1), cA + hstep, voffA);
        if (wr == 1) PG8_BAR;
        PG8_WAIT_V(2); PG8_BAR;
        PG8_STAGE(PG8_SB(1, 0), cB + kstep, voffB); PG8_STAGE(PG8_SA(1, 0), cA + kstep, voffA); PG8_STAGE(PG8_SB(1, 1), cB + hstep + kstep, voffB);
        PG8_WAIT_V(6); PG8_BAR;
    } else {
        PG8_STAGE(PG8_SB(0, 0), cB, voffB); PG8_STAGE(PG8_SA(0, 0), cA, voffA); PG8_STAGE(PG8_SB(0, 1), cB + hstep, voffB); PG8_STAGE(PG8_SA(0, 1), cA + hstep, voffA);
        if (wr == 1) PG8_BAR;
        PG8_WAIT_V(4); PG8_BAR;
        PG8_STAGE(PG8_SB(1, 0), cB + kstep, voffB); PG8_STAGE(PG8_SA(1, 0), cA + kstep, voffA); PG8_STAGE(PG8_SB(1, 1), cB + hstep + kstep, voffB);
        PG8_WAIT_V(6); PG8_BAR;
    }
    for (;;) {
        const bool has_next = S.next(ui + 1, nxt);
        const char* nA = has_next ? (const char*)g.A + (size_t)nxt.pm * tstep : cA; const char* nB = has_next ? (const char*)g.Bt + (size_t)nxt.pn * tstep : cB;
        for (int t = 0; t < nt; t += 2) {
            const bool last = (t == nt - 2);
            const char* a1 = cA + (size_t)(t + 1) * kstep;
            const char* a2 = last ? nA : cA + (size_t)(t + 2) * kstep; const char* b2 = last ? nB : cB + (size_t)(t + 2) * kstep;
            const char* a3 = a2 + kstep; const char* b3 = b2 + kstep;
            if (last && has_next) S.a_ready(nxt);
            if constexpr (SP2) {
            PG8_LDB(B0, 0, 0); PG8_LDB(B1, 0, 1); PG8_SCHED; PG8_LDA(At, 0, 0); PG8_STAGE(PG8_SA(1, 1), a1 + hstep, voffA);
            PG8_WAIT_V(8); PG8_WAIT_L(0); PG8_BAR; PG8_MMA(0, 0, At, B0); PG8_MMA(0, 1, At, B1); PG8_BAR; PG8_SCHED;
            PG8_LDA(At, 0, 1); PG8_STAGE(PG8_SB(0, 0), b2, voffB); PG8_STAGE(PG8_SB(0, 1), b2 + hstep, voffB); PG8_STAGE(PG8_SA(0, 0), a2, voffA);
            PG8_WAIT_V(8); PG8_WAIT_L(0); PG8_BAR; PG8_MMA(1, 0, At, B0); PG8_MMA(1, 1, At, B1); PG8_BAR; PG8_SCHED;
            PG8_LDB(B0, 1, 0); PG8_LDB(B1, 1, 1); PG8_SCHED; PG8_LDA(At, 1, 0); PG8_STAGE(PG8_SA(0, 1), a2 + hstep, voffA);
            PG8_WAIT_V(8); PG8_WAIT_L(0); PG8_BAR; PG8_MMA(0, 0, At, B0); PG8_MMA(0, 1, At, B1); PG8_BAR; PG8_SCHED;
            PG8_LDA(At, 1, 1); PG8_STAGE(PG8_SB(1, 0), b3, voffB); PG8_STAGE(PG8_SB(1, 1), b3 + hstep, voffB); PG8_STAGE(PG8_SA(1, 0), a3, voffA);
            PG8_WAIT_V(8); PG8_WAIT_L(0); PG8_BAR; PG8_MMA(1, 0, At, B0); PG8_MMA(1, 1, At, B1); PG8_BAR; PG8_SCHED;
            } else {
            PG8_LDB(B0, 0, 0); PG8_SCHED; PG8_LDA(At, 0, 0); PG8_STAGE(PG8_SA(1, 1), a1 + hstep, voffA);
            PG8_WAIT_L(8); PG8_BAR; PG8_WAIT_L(0); PG8_MMA(0, 0, At, B0); PG8_BAR; PG8_SCHED;
            PG8_LDB(B1, 0, 1); PG8_STAGE(PG8_SB(0, 0), b2, voffB);
            PG8_BAR; PG8_WAIT_L(0); PG8_MMA(0, 1, At, B1); PG8_BAR;
            PG8_LDA(At, 0, 1); PG8_STAGE(PG8_SA(0, 0), a2, voffA);
            PG8_BAR; PG8_WAIT_L(0); PG8_MMA(1, 0, At, B0); PG8_BAR; PG8_SCHED;
            PG8_STAGE(PG8_SB(0, 1), b2 + hstep, voffB);
            PG8_WAIT_V(6); PG8_BAR; PG8_MMA(1, 1, At, B1); PG8_BAR;
            PG8_LDB(B0, 1, 0); PG8_SCHED; PG8_LDA(At, 1, 0); PG8_STAGE(PG8_SA(0, 1), a2 + hstep, voffA);
            PG8_WAIT_L(8); PG8_BAR; PG8_WAIT_L(0); PG8_MMA(0, 0, At, B0); PG8_BAR; PG8_SCHED;
            PG8_LDB(B1, 1, 1); PG8_STAGE(PG8_SB(1, 0), b3, voffB);
            PG8_BAR; PG8_WAIT_L(0); PG8_MMA(0, 1, At, B1); PG8_BAR;
            PG8_LDA(At, 1, 1); PG8_STAGE(PG8_SA(1, 0), a3, voffA);
            PG8_BAR; PG8_WAIT_L(0); PG8_MMA(1, 0, At, B0); PG8_BAR; PG8_SCHED;
            PG8_STAGE(PG8_SB(1, 1), b3 + hstep, voffB);
            PG8_WAIT_V(6); PG8_BAR; PG8_MMA(1, 1, At, B1); PG8_BAR;
            }
        }
        if constexpr (ALIGN_EPI) { if (wr == 0) PG8_BAR; }
        if constexpr (!Epi::AFTER_DRAIN) { E(acc, cur, wr, wc, fr, fq); S.done(cur); }
        if (!has_next) break;
#pragma unroll
        for (int a = 0; a < 2; ++a)
#pragma unroll
            for (int b = 0; b < 2; ++b)
#pragma unroll
                for (int m = 0; m < 4; ++m)
#pragma unroll
                    for (int n = 0; n < 2; ++n) acc[a][b][m][n] = (f32x4){0.f, 0.f, 0.f, 0.f};
        cur = nxt; cA = nA; cB = nB; ++ui;
        if constexpr (ALIGN_EPI) { if (wr == 1) PG8_BAR; }
    }
    PG8_WAIT_V(0);
    if constexpr (!ALIGN_EPI) { if (wr == 0) PG8_BAR; }
    PG8_BAR;
    if constexpr (Epi::AFTER_DRAIN) { E.fused(acc, cur, wr, wc, fr, fq, lds, wid, lane); S.done(cur); }
#undef PG8_SA
#undef PG8_SB
#undef PG8_STAGE
#undef PG8_LDA
#undef PG8_LDB
#undef PG8_MMA
#undef PG8_WAIT_V
#undef PG8_WAIT_L
#undef PG8_BAR
#undef PG8_SCHED
}
}

#define LAS __attribute__((address_space(3)))
typedef unsigned short bf16_t;
typedef float f32x4 __attribute__((ext_vector_type(4)));
typedef float f32x2 __attribute__((ext_vector_type(2)));
typedef unsigned u32x4 __attribute__((ext_vector_type(4)));
typedef unsigned u32x2 __attribute__((ext_vector_type(2)));
typedef short bf16x8 __attribute__((ext_vector_type(8)));
typedef short s16x4 __attribute__((ext_vector_type(4)));

constexpr int DM = 1024, SEQ = 4096, NB = 4, MP = NB * SEQ;
constexpr int DB = 32, DS = 4, MS = DB * DS;
constexpr int MT = MP + MS;
constexpr int MPAD = 16640;
constexpr int PAST = 16384;
constexpr int NIN_A = 5120, DFF = 2816, NUP = 2 * DFF;
constexpr float EPS = 1e-6f;
constexpr float QSCALE = 0.08838834764831845f * 1.4426950408889634f;
constexpr float NEGBIG = -1e30f;

constexpr size_t O_YP = 0;
constexpr size_t O_YS = O_YP + (size_t)MP * DM;
constexpr size_t O_PW0 = O_YS + (size_t)MS * DM;
constexpr size_t O_PW1 = O_PW0 + (size_t)NB * 128 * 1024;
constexpr size_t O_PW2 = O_PW1 + (size_t)NB * 512 * 1024;
constexpr size_t O_PMEM = O_PW2 + (size_t)NB * 2048 * 1024;
constexpr size_t O_PS5 = O_PMEM + (size_t)2 * NB * 256 * 1024;
constexpr size_t O_PCONV = O_PS5 + (size_t)NB * 2 * 32 * 64;
constexpr size_t O_SW0 = O_PCONV + (size_t)2 * NB * 2 * NUP;
constexpr size_t O_SW1 = O_SW0 + (size_t)DB * 128 * 1024;
constexpr size_t O_SW2 = O_SW1 + (size_t)DB * 512 * 1024;
constexpr size_t O_SS5 = O_SW2 + (size_t)DB * 2048 * 1024;
constexpr size_t O_SCONV = O_SS5 + (size_t)DB * 2 * 32 * 64;
constexpr size_t O_END = O_SCONV + (size_t)2 * DB * 2 * NUP;
static_assert(O_END == 119054336, "output size");

constexpr size_t al256(size_t x) { return (x + 255) & ~(size_t)255; }
constexpr size_t WS_SUMSQ = 0;
constexpr size_t WS_BAR = 512u << 10;
constexpr size_t WS_WINA = 1u << 20;
constexpr size_t WS_WINB = WS_WINA + (size_t)NIN_A * DM * 2;
constexpr size_t WS_WGLU = WS_WINB + (size_t)DM * DM * 2;
constexpr size_t WS_WMKV = WS_WGLU + (size_t)512 * 512 * 2;
constexpr size_t WS_WOUT = WS_WMKV + (size_t)2 * DM * DM * 2;
constexpr size_t WS_WUP = WS_WOUT + (size_t)2 * DM * DM * 2;
constexpr size_t WS_WDN = WS_WUP + (size_t)2 * NUP * DM * 2;
constexpr size_t WS_HB = WS_WDN + (size_t)2 * DM * DFF * 2;
constexpr size_t WS_MEMN = WS_HB + (size_t)MPAD * DM * 2;
constexpr size_t WS_MKVR = WS_MEMN + (size_t)2 * DM * DM * 2;
constexpr size_t WS_MKV = WS_MKVR + (size_t)2 * DM * DM * 2;
constexpr size_t WS_SMKV = WS_MKV + (size_t)2 * DM * DM * 2;
constexpr size_t WS_PROJ = WS_SMKV + (size_t)2 * DB * 256 * 1024 * 2;
constexpr size_t WS_PROJ1 = WS_PROJ + (size_t)MPAD * NUP * 2;
constexpr size_t WS_OG = WS_PROJ1 + (size_t)MPAD * DM * 2;
constexpr size_t WS_L2G = WS_OG + (size_t)3 * MT * 512 * 2;
constexpr size_t WS_MERGED = al256(WS_L2G + (size_t)3 * MT * 4 * 4);
constexpr size_t WS_X = WS_MERGED + (size_t)MPAD * DM * 2;
constexpr size_t WS_ACT = WS_X + (size_t)MPAD * DM * 4;
constexpr size_t WS_Y = WS_ACT + (size_t)MPAD * DFF * 2;
constexpr size_t WS_E = WS_Y + (size_t)MPAD * 512 * 2;
constexpr size_t WS_SOG = WS_E + (size_t)NB * 64 * 32 * 64 * 8;
constexpr size_t WS_SL2 = WS_SOG + (size_t)12 * MS * 512 * 4;
constexpr size_t WS_BND = al256(WS_SL2 + (size_t)12 * MS * 4 * 4);
constexpr size_t WS_UPS = WS_BND + (size_t)258 * 4 * NUP * 2;
constexpr size_t WS_END = WS_UPS + (size_t)MS * NUP * 2;
static_assert(WS_END < (size_t)1000 * 1024 * 1024, "ws map");

constexpr int LDS_BYTES = 147456;

struct Args { const float* in[34]; float* out; unsigned char* ws; int ph_lo, ph_hi; };

__device__ __forceinline__ unsigned pk2(float lo, float hi) { return pg8::cvt_pk_bf16(lo, hi); }
__device__ __forceinline__ float bflo(unsigned w) { return __uint_as_float(w << 16); }
__device__ __forceinline__ float bfhi(unsigned w) { return __uint_as_float(w & 0xffff0000u); }
__device__ __forceinline__ float bf2f(bf16_t h) { return __uint_as_float(((unsigned)h) << 16); }
__device__ __forceinline__ bf16_t f2bf(float f) { return (bf16_t)(pk2(f, 0.f) & 0xffffu); }
__device__ __forceinline__ float wave_sum(float v) {
#pragma unroll
    for (int o = 1; o < 64; o <<= 1) v += __shfl_xor(v, o);
    return v;
}
__device__ __forceinline__ float wave_max(float v) {
#pragma unroll
    for (int o = 1; o < 64; o <<= 1) v = fmaxf(v, __shfl_xor(v, o));
    return v;
}
#define LDS_WAIT() asm volatile("s_waitcnt lgkmcnt(0)" ::: "memory")
__device__ __forceinline__ void unpack8(const u32x4 w, float (&x)[8]) { x[0] = bflo(w.x); x[1] = bfhi(w.x); x[2] = bflo(w.y); x[3] = bfhi(w.y); x[4] = bflo(w.z); x[5] = bfhi(w.z); x[6] = bflo(w.w); x[7] = bfhi(w.w); }
__device__ __forceinline__ void load8f(const float* p, float (&x)[8]) { const f32x4 a = *(const f32x4*)p, b = *(const f32x4*)(p + 4); x[0] = a[0]; x[1] = a[1]; x[2] = a[2]; x[3] = a[3]; x[4] = b[0]; x[5] = b[1]; x[6] = b[2]; x[7] = b[3]; }

struct EpiStoreBf16 {
    static constexpr bool PERM = true, AFTER_DRAIN = false;
    bf16_t* O; int ldc; const float* sumsq;
    __device__ __forceinline__ void operator()(const f32x4 (&acc)[2][2][4][2], const pg8::Unit& u, int wr, int wc, int fr, int fq) const {
        const int row0 = u.pm * 256 + wr * 64 + fr, col0 = u.pn * 256 + wc * 32 + 8 * fq;
#pragma unroll
        for (int ai = 0; ai < 2; ++ai)
#pragma unroll
            for (int m = 0; m < 4; ++m) {
                const int row = row0 + ai * 128 + m * 16;
                float sc = 1.f; if (sumsq) sc = rsqrtf(sumsq[row] * (1.f / 1024.f) + EPS);
                bf16_t* rowp = O + (size_t)row * ldc + col0;
#pragma unroll
                for (int bj = 0; bj < 2; ++bj) { const f32x4 v0 = acc[ai][bj][m][0] * sc, v1 = acc[ai][bj][m][1] * sc;
                    u32x4 w; w.x = pk2(v0[0], v0[1]); w.y = pk2(v0[2], v0[3]); w.z = pk2(v1[0], v1[1]); w.w = pk2(v1[2], v1[3]);
                    *(u32x4*)(rowp + bj * 128) = w; }
            }
    }
};
struct EpiGlu {
    static constexpr bool PERM = true, AFTER_DRAIN = false;
    bf16_t* O; int ldc; const bf16_t* Y; const float* bias;
    __device__ __forceinline__ void operator()(const f32x4 (&acc)[2][2][4][2], const pg8::Unit& u, int wr, int wc, int fr, int fq) const {
        const int row0 = u.pm * 256 + wr * 64 + fr, col0 = u.pn * 256 + wc * 32 + 8 * fq;
#pragma unroll
        for (int bj = 0; bj < 2; ++bj) {
            const f32x4 b0 = *(const f32x4*)(bias + col0 + bj * 128), b1 = *(const f32x4*)(bias + col0 + bj * 128 + 4);
#pragma unroll
            for (int ai = 0; ai < 2; ++ai)
#pragma unroll
                for (int m = 0; m < 4; ++m) {
                    const int row = row0 + ai * 128 + m * 16;
                    const u32x4 yw = *(const u32x4*)(Y + (size_t)row * 512 + col0 + bj * 128);
                    const f32x4 z0 = acc[ai][bj][m][0] + b0, z1 = acc[ai][bj][m][1] + b1;
                    float y[8] = {bflo(yw.x), bfhi(yw.x), bflo(yw.y), bfhi(yw.y), bflo(yw.z), bfhi(yw.z), bflo(yw.w), bfhi(yw.w)};
                    float o[8];
#pragma unroll
                    for (int e = 0; e < 4; ++e) { o[e] = y[e] * __builtin_amdgcn_rcpf(1.f + __expf(-z0[e])); o[4 + e] = y[4 + e] * __builtin_amdgcn_rcpf(1.f + __expf(-z1[e])); }
                    u32x4 w; w.x = pk2(o[0], o[1]); w.y = pk2(o[2], o[3]); w.z = pk2(o[4], o[5]); w.w = pk2(o[6], o[7]);
                    *(u32x4*)(O + (size_t)row * ldc + col0 + bj * 128) = w;
                }
        }
    }
};
struct EpiResidual {
    static constexpr bool PERM = false, AFTER_DRAIN = false;
    const float* base_p; const float* base_s; float* out_p; float* out_s; float* sumsq; bf16_t* hb; const float* g;
    __device__ __forceinline__ void operator()(const f32x4 (&acc)[2][2][4][2], const pg8::Unit& u, int wr, int wc, int fr, int fq) const {
        const int col0 = u.pn * 256 + wc * 32 + 4 * fq;
#pragma unroll
        for (int ai = 0; ai < 2; ++ai)
#pragma unroll
            for (int m = 0; m < 4; ++m) {
                const int row = u.pm * 256 + ai * 128 + wr * 64 + m * 16 + fr;
                float ss = 0.f;
                if (row < MT) {
                    const float* b = row < MP ? base_p + (size_t)row * DM : base_s + (size_t)(row - MP) * DM;
                    float* o = row < MP ? out_p + (size_t)row * DM : out_s + (size_t)(row - MP) * DM;
#pragma unroll
                    for (int bj = 0; bj < 2; ++bj)
#pragma unroll
                        for (int n = 0; n < 2; ++n) { const int c = col0 + bj * 128 + n * 16;
                            const f32x4 v = acc[ai][bj][m][n] + *(const f32x4*)(b + c);
                            *(f32x4*)(o + c) = v; ss += (v[0] * v[0] + v[1] * v[1]) + (v[2] * v[2] + v[3] * v[3]);
                            if (hb) { const f32x4 gv = *(const f32x4*)(g + c); u32x2 w; w.x = pk2(v[0] * gv[0], v[1] * gv[1]); w.y = pk2(v[2] * gv[2], v[3] * gv[3]);
                                *(u32x2*)(hb + (size_t)row * DM + c) = w; } }
                }
                ss += __shfl_xor(ss, 16); ss += __shfl_xor(ss, 32);
                if (sumsq && fq == 0 && row < MT) atomicAdd(sumsq + row, ss);
            }
    }
};


__device__ __forceinline__ float dpp_f(float oldv, float src, const int ctrl_sel) {
    const int o = __float_as_int(oldv), s = __float_as_int(src);
    int r;
    if (ctrl_sel == 0) r = __builtin_amdgcn_update_dpp(o, s, 0x121, 0xf, 0xf, false);
    else if (ctrl_sel == 1) r = __builtin_amdgcn_update_dpp(o, s, 0x122, 0xf, 0xf, false);
    else if (ctrl_sel == 2) r = __builtin_amdgcn_update_dpp(o, s, 0x111, 0xf, 0xf, false);
    else r = __builtin_amdgcn_update_dpp(o, s, 0x112, 0xf, 0xf, false);
    return __int_as_float(r);
}
struct EpiUpConv {
    static constexpr bool PERM = true, AFTER_DRAIN = false;
    bf16_t* ACT; const float* sumsq; const float* cw; const float* cb; bf16_t* BND; bf16_t* UPS;
    __device__ __forceinline__ void operator()(const f32x4 (&acc)[2][2][4][2], const pg8::Unit& u, int wr, int wc, int fr, int fq) const {
        const int chan0 = u.pn * 128 + wc * 32 + 8 * fq;
        if (u.pm == MP / 256) {
#pragma unroll
            for (int ai = 0; ai < 2; ++ai)
#pragma unroll
                for (int m = 0; m < 4; ++m) { const int row = u.pm * 256 + ai * 128 + wr * 64 + m * 16 + fr;
                    if (row < MT) { const float sc = rsqrtf(sumsq[row] * (1.f / 1024.f) + EPS);
#pragma unroll
                        for (int bj = 0; bj < 2; ++bj) { const f32x4 v0 = acc[ai][bj][m][0] * sc, v1 = acc[ai][bj][m][1] * sc;
                            u32x4 w; w.x = pk2(v0[0], v0[1]); w.y = pk2(v0[2], v0[3]); w.z = pk2(v1[0], v1[1]); w.w = pk2(v1[2], v1[3]);
                            *(u32x4*)(UPS + ((size_t)(row - MP) * 2 + bj) * DFF + chan0) = w; } } }
            return;
        }
#pragma unroll
        for (int n2 = 0; n2 < 2; ++n2) {
            const int ch = chan0 + 4 * n2;
            f32x4 wa[3], wb[3];
#pragma unroll
            for (int j = 0; j < 3; ++j) { wa[j] = *(const f32x4*)(cw + j * NUP + ch); wb[j] = *(const f32x4*)(cw + j * NUP + DFF + ch); }
            const f32x4 ba = *(const f32x4*)(cb + ch), bb = *(const f32x4*)(cb + DFF + ch);
#pragma unroll
            for (int ai = 0; ai < 2; ++ai) {
                f32x4 pa = {0.f, 0.f, 0.f, 0.f}, pb = {0.f, 0.f, 0.f, 0.f};
#pragma unroll
                for (int m = 0; m < 4; ++m) {
                    const int row = u.pm * 256 + ai * 128 + wr * 64 + m * 16 + fr;
                    const float sc = rsqrtf(sumsq[row] * (1.f / 1024.f) + EPS);
                    const f32x4 ca = acc[ai][0][m][n2] * sc, cbv = acc[ai][1][m][n2] * sc;
                    if ((m == 0 && fr < 2) || (m == 3 && fr >= 14)) { const int slab = row >> 6, k = (m == 0) ? fr : fr - 12;
                        u32x2 w; w.x = pk2(ca[0], ca[1]); w.y = pk2(ca[2], ca[3]); *(u32x2*)(BND + ((size_t)(slab * 4 + k) * 2 + 0) * DFF + ch) = w;
                        w.x = pk2(cbv[0], cbv[1]); w.y = pk2(cbv[2], cbv[3]); *(u32x2*)(BND + ((size_t)(slab * 4 + k) * 2 + 1) * DFF + ch) = w; }
                    f32x4 o;
#pragma unroll
                    for (int e = 0; e < 4; ++e) {
                        const float a1 = dpp_f(dpp_f(0.f, pa[e], 0), ca[e], 2), a2 = dpp_f(dpp_f(0.f, pa[e], 1), ca[e], 3);
                        const float b1 = dpp_f(dpp_f(0.f, pb[e], 0), cbv[e], 2), b2 = dpp_f(dpp_f(0.f, pb[e], 1), cbv[e], 3);
                        const float A = ba[e] + wa[0][e] * a2 + wa[1][e] * a1 + wa[2][e] * ca[e];
                        const float B = bb[e] + wb[0][e] * b2 + wb[1][e] * b1 + wb[2][e] * cbv[e];
                        o[e] = A / (1.f + __expf(-A)) * B; }
                    u32x2 w; w.x = pk2(o[0], o[1]); w.y = pk2(o[2], o[3]);
                    *(u32x2*)(ACT + (size_t)row * DFF + ch) = w;
                    pa = ca; pb = cbv;
                }
            }
        }
    }
};

template <class F> __device__ __forceinline__ void skinny_gemm(const bf16_t* A, const bf16_t* Bt, int K, int N, const F& f) {
    const int lane = threadIdx.x & 63, wave = threadIdx.x >> 6, l16 = lane & 15, quad = lane >> 4;
    const int gwr = ((int)gridDim.x - 1 - (int)blockIdx.x) * 8 + wave, NGW = gridDim.x * 8;
    const int ntile = 8 * (N >> 4);
    for (int wi = gwr; wi < ntile; wi += NGW) {
        const int rt = wi & 7, ct = wi >> 3;
        const bf16_t* ap = A + (size_t)(MP + rt * 16 + l16) * K + quad * 8;
        const bf16_t* bp = Bt + (size_t)(ct * 16 + l16) * K + quad * 8;
        f32x4 acc0 = {0.f, 0.f, 0.f, 0.f}, acc1 = {0.f, 0.f, 0.f, 0.f};
        int k = 0;
        for (; k + 512 <= K; k += 512) {
            bf16x8 af[16], bf[16];
#pragma unroll
            for (int u = 0; u < 16; ++u) { af[u] = *(const bf16x8*)(ap + k + u * 32); bf[u] = *(const bf16x8*)(bp + k + u * 32); }
#pragma unroll
            for (int u = 0; u < 16; u += 2) { acc0 = __builtin_amdgcn_mfma_f32_16x16x32_bf16(af[u], bf[u], acc0, 0, 0, 0); acc1 = __builtin_amdgcn_mfma_f32_16x16x32_bf16(af[u + 1], bf[u + 1], acc1, 0, 0, 0); }
        }
        for (; k < K; k += 256) {
            bf16x8 af[8], bf[8];
#pragma unroll
            for (int u = 0; u < 8; ++u) { af[u] = *(const bf16x8*)(ap + k + u * 32); bf[u] = *(const bf16x8*)(bp + k + u * 32); }
#pragma unroll
            for (int u = 0; u < 8; u += 2) { acc0 = __builtin_amdgcn_mfma_f32_16x16x32_bf16(af[u], bf[u], acc0, 0, 0, 0); acc1 = __builtin_amdgcn_mfma_f32_16x16x32_bf16(af[u + 1], bf[u + 1], acc1, 0, 0, 0); }
        }
        const f32x4 acc = acc0 + acc1;
#pragma unroll
        for (int j = 0; j < 4; ++j) f(MP + rt * 16 + quad * 4 + j, ct * 16 + l16, acc[j]);
    }
}

template <class F> __device__ __forceinline__ void skinny_gemm_splitk(const bf16_t* A, const bf16_t* Bt, int K, int N, const F& f, LAS unsigned char* lds) {
    const int lane = threadIdx.x & 63, wave = threadIdx.x >> 6, l16 = lane & 15, quad = lane >> 4;
    const int nunit = 8 * (N >> 4), nks = K >> 8;
    LAS f32x4* part = (LAS f32x4*)lds;
    for (int un = (int)gridDim.x - 1 - (int)blockIdx.x; un < nunit; un += gridDim.x) {
        const int rt = un & 7, ct = un >> 3;
        const bf16_t* ap = A + (size_t)(MP + rt * 16 + l16) * K + wave * (K >> 3) + quad * 8;
        const bf16_t* bp = Bt + (size_t)(ct * 16 + l16) * K + wave * (K >> 3) + quad * 8;
        bf16x8 af[11], bf[11];
#pragma unroll
        for (int u = 0; u < 11; ++u) if (u < nks) { af[u] = *(const bf16x8*)(ap + u * 32); bf[u] = *(const bf16x8*)(bp + u * 32); }
        f32x4 acc = {0.f, 0.f, 0.f, 0.f};
#pragma unroll
        for (int u = 0; u < 11; ++u) if (u < nks) acc = __builtin_amdgcn_mfma_f32_16x16x32_bf16(af[u], bf[u], acc, 0, 0, 0);
        asm volatile("s_nop 15\n\ts_nop 15" : "+v"(acc));
        part[wave * 64 + lane] = acc;
        __syncthreads();
        if (wave == 0) {
            f32x4 s = part[lane];
#pragma unroll
            for (int w = 1; w < 8; ++w) s += part[w * 64 + lane];
#pragma unroll
            for (int j = 0; j < 4; ++j) f(MP + rt * 16 + quad * 4 + j, ct * 16 + l16, s[j]);
        }
        __syncthreads();
    }
}
struct SkStore { bf16_t* O; int ldc; const float* sumsq;
    __device__ __forceinline__ void operator()(int row, int col, float v) const { float sc = 1.f; if (sumsq) sc = rsqrtf(sumsq[row] * (1.f / 1024.f) + EPS); O[(size_t)row * ldc + col] = f2bf(v * sc); } };
struct SkGlu { bf16_t* O; int ldc; const bf16_t* Y; const float* bias;
    __device__ __forceinline__ void operator()(int row, int col, float v) const { const float y = bf2f(Y[(size_t)row * 512 + col]); O[(size_t)row * ldc + col] = f2bf(y / (1.f + __expf(-(v + bias[col])))); } };
struct SkResidual { const float* base_s; float* out_s; float* sumsq; bf16_t* hb; const float* g;
    __device__ __forceinline__ void operator()(int row, int col, float v) const {
        const float xn = base_s[(size_t)(row - MP) * DM + col] + v; out_s[(size_t)(row - MP) * DM + col] = xn;
        float ss = xn * xn; ss += __shfl_xor(ss, 1); ss += __shfl_xor(ss, 2); ss += __shfl_xor(ss, 4); ss += __shfl_xor(ss, 8);
        if (sumsq && (threadIdx.x & 15) == 0) atomicAdd(sumsq + row, ss);
        if (hb) hb[(size_t)row * DM + col] = f2bf(xn * g[col]); } };

__device__ __forceinline__ void transpose_item(const float* W, int K, int N, bf16_t* WT, LAS float* scr, int item, int lane, const bool up_perm = false) {
    const int nblk = N / 32, kb = item / nblk, nb = item % nblk, k0 = 64 * kb, n0 = 32 * nb;
    float tv[32];
#pragma unroll
    for (int i = 0; i < 32; ++i) { const int kk = 2 * i + (lane >> 5); tv[i] = W[(size_t)(k0 + kk) * N + n0 + (lane & 31)]; }
#pragma unroll
    for (int i = 0; i < 32; ++i) { const int kk = 2 * i + (lane >> 5); scr[kk * 33 + (lane & 31)] = tv[i]; }
    LDS_WAIT();
    const int c = lane & 7;
#pragma unroll
    for (int j = 0; j < 4; ++j) { const int n = (lane >> 3) + 8 * j; const LAS float* s = scr + (8 * c) * 33 + n;
        u32x4 o; o.x = pk2(s[0 * 33], s[1 * 33]); o.y = pk2(s[2 * 33], s[3 * 33]); o.z = pk2(s[4 * 33], s[5 * 33]); o.w = pk2(s[6 * 33], s[7 * 33]);
        int nr = n0 + n; if (up_perm) { const int half = nr >= DFF ? 1 : 0, chn = nr - half * DFF; nr = (chn >> 7) * 256 + half * 128 + (chn & 127); }
        *(u32x4*)(WT + (size_t)nr * K + k0 + 8 * c) = o; }
    LDS_WAIT();
}
__device__ __forceinline__ void rms_row_to_bf16(const float* xrow, const float* g, bf16_t* orow, int lane) {
    const f32x4* xr = (const f32x4*)xrow + lane; const f32x4* gr = (const f32x4*)g + lane;
    f32x4 v[4]; float s = 0.f;
#pragma unroll
    for (int j = 0; j < 4; ++j) { v[j] = xr[64 * j]; s += (v[j].x * v[j].x + v[j].y * v[j].y) + (v[j].z * v[j].z + v[j].w * v[j].w); }
    const float r = rsqrtf(wave_sum(s) * (1.f / 1024.f) + EPS);
    u32x2* o8 = (u32x2*)orow + lane;
#pragma unroll
    for (int j = 0; j < 4; ++j) { const f32x4 gv = gr[64 * j]; u32x2 w; w.x = pk2(v[j].x * r * gv.x, v[j].y * r * gv.y); w.y = pk2(v[j].z * r * gv.z, v[j].w * r * gv.w); o8[64 * j] = w; }
}

template <int L> __device__ __forceinline__ void win_copy(const float* src, float* dst, size_t lo, size_t hi, size_t tw, size_t stride) {
    constexpr size_t per = (size_t)(L - DS) * 256;
    const f32x4* s4 = (const f32x4*)src; f32x4* d4 = (f32x4*)dst;
    for (size_t i0 = lo + tw; i0 < hi; i0 += stride * 16) {
        f32x4 v[16]; size_t di[16];
#pragma unroll
        for (int u = 0; u < 16; ++u) { const size_t i = i0 + u * stride; const bool ok = i < hi; const size_t ii = ok ? i : lo; const size_t b = ii / per, rem = ii - b * per;
            di[u] = ok ? b * (size_t)L * 256 + rem : ~(size_t)0; v[u] = __builtin_nontemporal_load(s4 + b * (size_t)L * 256 + 1024 + rem); }
#pragma unroll
        for (int u = 0; u < 16; ++u) if (di[u] != ~(size_t)0) __builtin_nontemporal_store(v[u], d4 + di[u]);
    }
}
constexpr size_t W2_N = (size_t)(2048 - DS) * 256 * DB;
constexpr size_t W2_A = 0, W2_B = 0, W2_C = 0;


constexpr int WCH = 4096;
constexpr unsigned WN2 = (2048 - DS) * 256 * DB, WN1 = (512 - DS) * 256 * DB, WN0 = (128 - DS) * 256 * DB;
constexpr int WC2 = (WN2 + WCH - 1) / WCH, WC1 = (WN1 + WCH - 1) / WCH, WC0 = (WN0 + WCH - 1) / WCH, WCT = WC2 + WC1 + WC0;
__device__ __forceinline__ void win_chunk(const Args& a, int c) {
    int g, cl; if (c < WC2) { g = 2; cl = c; } else if (c < WC2 + WC1) { g = 1; cl = c - WC2; } else { g = 0; cl = c - WC2 - WC1; }
    const unsigned L = 128u << (2 * g), per = (L - DS) * 256u, n = per * DB;
    const f32x4* s4 = (const f32x4*)(g == 2 ? a.in[4] : g == 1 ? a.in[3] : a.in[2]);
    f32x4* d4 = (f32x4*)(a.out + (g == 2 ? O_SW2 : g == 1 ? O_SW1 : O_SW0));
    f32x4 v[8]; unsigned di[8];
#pragma unroll
    for (int u = 0; u < 8; ++u) { const unsigned i = (unsigned)cl * WCH + u * 512 + threadIdx.x; const bool ok = i < n; const unsigned ii = ok ? i : 0u; const unsigned b = ii / per, rem = ii - b * per;
        di[u] = ok ? b * (L * 256u) + rem : 0xffffffffu; v[u] = __builtin_nontemporal_load(s4 + (size_t)(b * (L * 256u) + 1024u + rem)); }
#pragma unroll
    for (int u = 0; u < 8; ++u) if (di[u] != 0xffffffffu) __builtin_nontemporal_store(v[u], d4 + (size_t)di[u]);
}
__device__ __forceinline__ void win_share(const Args& a, int lo, int hi) { for (int cc = lo + (int)blockIdx.x; cc < hi; cc += gridDim.x) win_chunk(a, cc); }
constexpr int WCA = 1100, WCB = 2100, WCC = 3052;
constexpr int WCD = WCC + 1100, WCE = WCD + 600;
__device__ __forceinline__ void win_idle(const Args& a, int lo, int hi, int first) { const int nb = (int)gridDim.x - first; if ((int)blockIdx.x < first || nb <= 0) return; for (int cc = lo + (int)blockIdx.x - first; cc < hi; cc += nb) win_chunk(a, cc); }

__device__ __forceinline__ void phase_prep(const Args& a, LAS unsigned char* lds) {
    const int tid = threadIdx.x, lane = tid & 63, wave = tid >> 6;
    const int gw = blockIdx.x * 8 + wave, NGW = gridDim.x * 8;
    const size_t gtid = (size_t)blockIdx.x * 512 + tid, nth = (size_t)gridDim.x * 512;
    unsigned char* ws = a.ws;
    { float* sq = (float*)(ws + WS_SUMSQ); for (size_t i = gtid; i < 3 * MPAD; i += nth) sq[i] = 0.f; }
    LAS float* scr = (LAS float*)(lds + wave * 16384);
    constexpr int I_INA = 16 * 160, I_SQ = 16 * 32, I_GLU = 8 * 16, I_UP = 16 * 176, I_DN = 44 * 32;
    constexpr int NITEMS = I_INA + I_SQ + I_GLU + 4 * I_SQ + 2 * I_UP + 2 * I_DN;
    for (int it = gw; it < NITEMS; it += NGW) {
        int r = it;
        if (r < I_INA) { transpose_item(a.in[11], 1024, NIN_A, (bf16_t*)(ws + WS_WINA), scr, r, lane); continue; } r -= I_INA;
        if (r < I_SQ) { transpose_item(a.in[14], 1024, 1024, (bf16_t*)(ws + WS_WINB), scr, r, lane); continue; } r -= I_SQ;
        if (r < I_GLU) { transpose_item(a.in[23], 512, 512, (bf16_t*)(ws + WS_WGLU), scr, r, lane); continue; } r -= I_GLU;
        if (r < 2 * I_SQ) { const int i = r / I_SQ; transpose_item(a.in[26] + (size_t)i * DM * DM, 1024, 1024, (bf16_t*)(ws + WS_WMKV) + (size_t)i * DM * DM, scr, r - i * I_SQ, lane); continue; } r -= 2 * I_SQ;
        if (r < 2 * I_SQ) { const int i = r / I_SQ; transpose_item(a.in[29] + (size_t)i * DM * DM, 1024, 1024, (bf16_t*)(ws + WS_WOUT) + (size_t)i * DM * DM, scr, r - i * I_SQ, lane); continue; } r -= 2 * I_SQ;
        if (r < 2 * I_UP) { const int i = r / I_UP; transpose_item(a.in[30] + (size_t)i * DM * NUP, 1024, NUP, (bf16_t*)(ws + WS_WUP) + (size_t)i * DM * NUP, scr, r - i * I_UP, lane, true); continue; } r -= 2 * I_UP;
        { const int i = r / I_DN; transpose_item(a.in[33] + (size_t)i * DFF * DM, DFF, 1024, (bf16_t*)(ws + WS_WDN) + (size_t)i * DFF * DM, scr, r - i * I_DN, lane); }
    }
    bf16_t* HB = (bf16_t*)(ws + WS_HB);
    for (int m = gw; m < MP; m += 2 * NGW) {
        const int m2 = m + NGW;
        const f32x4* x0 = (const f32x4*)(a.in[0] + (size_t)m * DM) + lane; const f32x4* x1 = (const f32x4*)(a.in[0] + (size_t)(m2 < MP ? m2 : m) * DM) + lane;
        f32x4 v0[4], v1[4]; float s0 = 0.f, s1 = 0.f;
#pragma unroll
        for (int j = 0; j < 4; ++j) { v0[j] = x0[64 * j]; v1[j] = x1[64 * j]; }
#pragma unroll
        for (int j = 0; j < 4; ++j) { s0 += (v0[j].x * v0[j].x + v0[j].y * v0[j].y) + (v0[j].z * v0[j].z + v0[j].w * v0[j].w); s1 += (v1[j].x * v1[j].x + v1[j].y * v1[j].y) + (v1[j].z * v1[j].z + v1[j].w * v1[j].w); }
        const float r0 = rsqrtf(wave_sum(s0) * (1.f / 1024.f) + EPS), r1 = rsqrtf(wave_sum(s1) * (1.f / 1024.f) + EPS);
        const f32x4* gr = (const f32x4*)a.in[9] + lane;
        u32x2* o0 = (u32x2*)(HB + (size_t)m * DM) + lane; u32x2* o1 = (u32x2*)(HB + (size_t)m2 * DM) + lane;
#pragma unroll
        for (int j = 0; j < 4; ++j) { const f32x4 gv = gr[64 * j];
            u32x2 w; w.x = pk2(v0[j].x * r0 * gv.x, v0[j].y * r0 * gv.y); w.y = pk2(v0[j].z * r0 * gv.z, v0[j].w * r0 * gv.w); o0[64 * j] = w;
            if (m2 < MP) { u32x2 w2; w2.x = pk2(v1[j].x * r1 * gv.x, v1[j].y * r1 * gv.y); w2.y = pk2(v1[j].z * r1 * gv.z, v1[j].w * r1 * gv.w); o1[64 * j] = w2; } }
    }
    for (int m = MP + gw; m < MPAD; m += NGW) {
        if (m < MT) rms_row_to_bf16(a.in[1] + (size_t)(m - MP) * DM, a.in[9], HB + (size_t)m * DM, lane);
        else { u32x4 z = {0u, 0u, 0u, 0u}; u32x4* o = (u32x4*)(HB + (size_t)m * DM); o[lane] = z; o[lane + 64] = z; }
    }
    for (int m = gw; m < 2048; m += NGW) { const int i = m >> 10, r = m & 1023;
        rms_row_to_bf16(a.in[8] + (size_t)r * DM, a.in[25] + i * DM, (bf16_t*)(ws + WS_MEMN) + (size_t)m * DM, lane); }
}

__device__ __constant__ double ROPE_INV_TURNS[16] = {0.15915494309189535, 0.07008652158779852, 0.030863763404701233, 0.013591370636193905, 0.005985185712713706, 0.002635675898667413, 0.001160663641240061, 0.0005111175045375439,
    0.00022507907903927658, 9.91173093690194e-05, 4.364795279280288e-05, 1.922110068494486e-05, 8.464330808241401e-06, 3.7274086019153524e-06, 1.641426262795035e-06, 7.228293068832867e-07};

__device__ __forceinline__ void p2_row(const Args& a, int row, int lane) {
    bf16_t* pr = (bf16_t*)(a.ws + WS_PROJ) + (size_t)row * NIN_A;
    const int l16 = lane & 15, hq = lane >> 4;
    const bool samp = row >= MP;
    int b, pos;
    if (!samp) { b = row >> 12; pos = row & 4095; } else { b = (row - MP) >> 2; pos = PAST + ((row - MP) & 3); }
    u32x4 w[9];
#pragma unroll
    for (int i = 0; i < 9; ++i) w[i] = *(const u32x4*)(pr + i * 512 + lane * 8);
    float cs[8], sn[8];
#pragma unroll
    for (int e = 0; e < 8; ++e) { const int j = (8 * l16 + e) & 15; double t = (double)pos * ROPE_INV_TURNS[j]; t -= floor(t); cs[e] = __builtin_amdgcn_cosf((float)t); sn[e] = __builtin_amdgcn_sinf((float)t); }
    const float sgn = (l16 < 2) ? -1.f : 1.f;
    int slot[3]; size_t obase[3];
#pragma unroll
    for (int g = 0; g < 3; ++g) { const int W = 128 << (2 * g);
        obase[g] = g == 0 ? (samp ? O_SW0 : O_PW0) : g == 1 ? (samp ? O_SW1 : O_PW1) : (samp ? O_SW2 : O_PW2);
        slot[g] = samp ? (W - DS + (pos - PAST)) : (pos - (SEQ - W)); }
#pragma unroll
    for (int i = 0; i < 6; ++i) {
        const int which = i / 3, g = i % 3;
        float x[8]; unpack8(w[i], x);
        float ss = 0.f;
#pragma unroll
        for (int e = 0; e < 8; ++e) ss += x[e] * x[e];
        ss += __shfl_xor(ss, 1); ss += __shfl_xor(ss, 2); ss += __shfl_xor(ss, 4); ss += __shfl_xor(ss, 8);
        const float r = rsqrtf(ss * (1.f / 128.f) + EPS);
        float gn[8]; load8f((which == 0 ? a.in[12] : a.in[13]) + g * 128 + 8 * l16, gn);
#pragma unroll
        for (int e = 0; e < 8; ++e) x[e] *= r * gn[e];
        float pt[8];
#pragma unroll
        for (int e = 0; e < 8; ++e) pt[e] = __shfl_xor(x[e], 2);
        if (l16 < 4) {
#pragma unroll
            for (int e = 0; e < 8; ++e) x[e] = x[e] * cs[e] + sgn * pt[e] * sn[e]; }
        if (which == 0) {
            u32x4 o; o.x = pk2(x[0] * QSCALE, x[1] * QSCALE); o.y = pk2(x[2] * QSCALE, x[3] * QSCALE); o.z = pk2(x[4] * QSCALE, x[5] * QSCALE); o.w = pk2(x[6] * QSCALE, x[7] * QSCALE);
            *(u32x4*)(pr + i * 512 + lane * 8) = o;
        } else {
            u32x4 o; o.x = pk2(x[0], x[1]); o.y = pk2(x[2], x[3]); o.z = pk2(x[4], x[5]); o.w = pk2(x[6], x[7]);
            *(u32x4*)(pr + i * 512 + lane * 8) = o;
            const int W = 128 << (2 * g);
            if (slot[g] >= 0) { float* op = a.out + obase[g] + (((size_t)b * W + slot[g]) * 2 + 0) * 512 + hq * 128 + 8 * l16;
                *(f32x4*)op = (f32x4){x[0], x[1], x[2], x[3]}; *(f32x4*)(op + 4) = (f32x4){x[4], x[5], x[6], x[7]}; }
        }
    }
#pragma unroll
    for (int g = 0; g < 3; ++g) {
        const int W = 128 << (2 * g);
        if (slot[g] >= 0) { float x[8]; unpack8(w[6 + g], x);
            float* op = a.out + obase[g] + (((size_t)b * W + slot[g]) * 2 + 1) * 512 + hq * 128 + 8 * l16;
            *(f32x4*)op = (f32x4){x[0], x[1], x[2], x[3]}; *(f32x4*)(op + 4) = (f32x4){x[4], x[5], x[6], x[7]}; }
    }
}
__device__ __forceinline__ void p2_memrow(const Args& a, int m, int lane) {
    const int i = m >> 10, l16 = lane & 15;
    const bf16_t* src = (const bf16_t*)(a.ws + WS_MKVR) + (size_t)m * DM; bf16_t* dst = (bf16_t*)(a.ws + WS_MKV) + (size_t)m * DM;
    float* out = a.out + O_PMEM + (size_t)m * DM;
    const u32x4 wk = *(const u32x4*)(src + lane * 8), wv = *(const u32x4*)(src + 512 + lane * 8);
    float x[8]; unpack8(wk, x);
    float ss = 0.f;
#pragma unroll
    for (int e = 0; e < 8; ++e) ss += x[e] * x[e];
    ss += __shfl_xor(ss, 1); ss += __shfl_xor(ss, 2); ss += __shfl_xor(ss, 4); ss += __shfl_xor(ss, 8);
    const float r = rsqrtf(ss * (1.f / 128.f) + EPS);
    float gn[8]; load8f(a.in[28] + i * 128 + 8 * l16, gn);
#pragma unroll
    for (int e = 0; e < 8; ++e) x[e] *= r * gn[e];
    u32x4 o; o.x = pk2(x[0], x[1]); o.y = pk2(x[2], x[3]); o.z = pk2(x[4], x[5]); o.w = pk2(x[6], x[7]);
    *(u32x4*)(dst + lane * 8) = o; *(u32x4*)(dst + 512 + lane * 8) = wv;
    *(f32x4*)(out + lane * 8) = (f32x4){x[0], x[1], x[2], x[3]}; *(f32x4*)(out + lane * 8 + 4) = (f32x4){x[4], x[5], x[6], x[7]};
    float v[8]; unpack8(wv, v);
    *(f32x4*)(out + 512 + lane * 8) = (f32x4){v[0], v[1], v[2], v[3]}; *(f32x4*)(out + 512 + lane * 8 + 4) = (f32x4){v[4], v[5], v[6], v[7]};
}

struct AttnDesc {
    const bf16_t* Q; long qs;
    const bf16_t* K; const bf16_t* V; long ks;
    int jmin; int band;
    const float* gq;
    const float* Kf; const float* Vf;
    bf16_t* O; long os; float* L2; long ls; int nvalid;
};
__device__ __forceinline__ void attn_load1(const bf16_t* base, const float* basef, long ks, int jmin, u32x4 (&r)[8]) {
    const int tid = threadIdx.x;
    if (basef) {
#pragma unroll
        for (int h = 0; h < 2; ++h) { f32x4 lo[4], hi[4];
#pragma unroll
            for (int i = 0; i < 4; ++i) { const int id = (h * 4 + i) * 512 + tid, key = id >> 4, ch = id & 15; const float* p = basef + (long)key * ks + ch * 8; lo[i] = *(const f32x4*)p; hi[i] = *(const f32x4*)(p + 4); }
#pragma unroll
            for (int i = 0; i < 4; ++i) { u32x4 w; w.x = pk2(lo[i][0], lo[i][1]); w.y = pk2(lo[i][2], lo[i][3]); w.z = pk2(hi[i][0], hi[i][1]); w.w = pk2(hi[i][2], hi[i][3]); r[h * 4 + i] = w; } }
        return;
    }
#pragma unroll
    for (int it = 0; it < 8; ++it) { const int id = it * 512 + tid, key = id >> 4, ch = id & 15;
        if (key >= jmin) r[it] = *(const u32x4*)(base + (long)key * ks + ch * 8); else r[it] = (u32x4){0u, 0u, 0u, 0u}; }
}
__device__ __forceinline__ void attn_stageK(const u32x4 (&kr)[8], LAS unsigned char* lds) {
    const int tid = threadIdx.x;
#pragma unroll
    for (int it = 0; it < 8; ++it) { const int id = it * 512 + tid, key = id >> 4, ch = id & 15;
        *(LAS u32x4*)(lds + key * 256 + ((ch ^ (key & 15)) << 4)) = kr[it]; }
}
__device__ __forceinline__ void attn_stageV(const u32x4 (&vr)[8], LAS unsigned char* lds) {
    const int tid = threadIdx.x;
    LAS unsigned char* Vl = lds + 65536;
#pragma unroll
    for (int it = 0; it < 8; ++it) { const int id = it * 512 + tid, key = id >> 4, ch = id & 15;
        *(LAS u32x4*)(Vl + key * 256 + ((((ch >> 1) ^ (key & 7)) << 5) | ((ch & 1) << 4))) = vr[it]; }
}
__device__ __forceinline__ void attn_qload(const AttnDesc& d, bf16x8 (&qf)[4]) {
    const int lane = threadIdx.x & 63, w = threadIdx.x >> 6, l16 = lane & 15, quad = lane >> 4;
    const bf16_t* qp = d.Q + (long)(16 * w + l16) * d.qs + quad * 8;
    u32x4 qr[4];
#pragma unroll
    for (int ks = 0; ks < 4; ++ks) qr[ks] = *(const u32x4*)(qp + ks * 32);
    if (d.gq) {
        float ss = 0.f;
#pragma unroll
        for (int ks = 0; ks < 4; ++ks) { const float x[8] = {bflo(qr[ks].x), bfhi(qr[ks].x), bflo(qr[ks].y), bfhi(qr[ks].y), bflo(qr[ks].z), bfhi(qr[ks].z), bflo(qr[ks].w), bfhi(qr[ks].w)};
#pragma unroll
            for (int e = 0; e < 8; ++e) ss += x[e] * x[e]; }
        ss += __shfl_xor(ss, 16); ss += __shfl_xor(ss, 32);
        const float r = rsqrtf(ss * (1.f / 128.f) + EPS) * QSCALE;
#pragma unroll
        for (int ks = 0; ks < 4; ++ks) { const f32x4 g0 = *(const f32x4*)(d.gq + ks * 32 + quad * 8), g1 = *(const f32x4*)(d.gq + ks * 32 + quad * 8 + 4);
            qr[ks].x = pk2(bflo(qr[ks].x) * r * g0[0], bfhi(qr[ks].x) * r * g0[1]); qr[ks].y = pk2(bflo(qr[ks].y) * r * g0[2], bfhi(qr[ks].y) * r * g0[3]);
            qr[ks].z = pk2(bflo(qr[ks].z) * r * g1[0], bfhi(qr[ks].z) * r * g1[1]); qr[ks].w = pk2(bflo(qr[ks].w) * r * g1[2], bfhi(qr[ks].w) * r * g1[3]); }
    }
#pragma unroll
    for (int ks = 0; ks < 4; ++ks) qf[ks] = __builtin_bit_cast(bf16x8, qr[ks]);
}
__device__ __forceinline__ void attn_compute(const AttnDesc& d, const bf16x8 (&qf)[4], LAS unsigned char* lds, const bool has, const AttnDesc& dn, u32x4 (&kr)[8], u32x4 (&vr)[8]) {
    const int tid = threadIdx.x, lane = tid & 63, w = tid >> 6, l16 = lane & 15, quad = lane >> 4;
    LAS unsigned char* Kl = lds; LAS unsigned char* Vl = lds + 65536;
    const int band = d.band;
    f32x4 s[16];
#pragma unroll
    for (int n = 0; n < 16; ++n) {
        s[n] = (f32x4){0.f, 0.f, 0.f, 0.f};
        if (!band || (n >= w && n <= w + 8)) {
#pragma unroll
            for (int ks = 0; ks < 4; ++ks) {
                const bf16x8 kf = *(const LAS bf16x8*)(Kl + (16 * n + l16) * 256 + ((((ks << 2) | quad) ^ l16) << 4));
                s[n] = __builtin_amdgcn_mfma_f32_16x16x32_bf16(kf, qf[ks], s[n], 0, 0, 0);
            }
        }
    }
    const int qi = 16 * w + l16;
    float mx = NEGBIG;
#pragma unroll
    for (int n = 0; n < 16; ++n)
#pragma unroll
        for (int j = 0; j < 4; ++j) { const int jj = 16 * n + 4 * quad + j;
            if (band) { const bool ok = (jj >= qi) && (jj <= qi + 128) && (jj >= d.jmin); s[n][j] = ok ? s[n][j] : NEGBIG; }
            mx = fmaxf(mx, s[n][j]); }
    mx = fmaxf(mx, __shfl_xor(mx, 16)); mx = fmaxf(mx, __shfl_xor(mx, 32));
    float lsum = 0.f;
#pragma unroll
    for (int n = 0; n < 16; ++n)
#pragma unroll
        for (int j = 0; j < 4; ++j) { const float p = __builtin_amdgcn_exp2f(s[n][j] - mx); s[n][j] = p; lsum += p; }
    lsum += __shfl_xor(lsum, 16); lsum += __shfl_xor(lsum, 32);
    bf16x8 pf[8];
#pragma unroll
    for (int k2 = 0; k2 < 8; ++k2) { u32x4 t; t.x = pk2(s[2 * k2][0], s[2 * k2][1]); t.y = pk2(s[2 * k2][2], s[2 * k2][3]); t.z = pk2(s[2 * k2 + 1][0], s[2 * k2 + 1][1]); t.w = pk2(s[2 * k2 + 1][2], s[2 * k2 + 1][3]);
        pf[k2] = __builtin_bit_cast(bf16x8, t); }
    attn_stageV(vr, lds);
    __syncthreads();
    if (has) attn_load1(dn.K, dn.Kf, dn.ks, dn.jmin, kr);
    f32x4 o[8];
#pragma unroll
    for (int nd = 0; nd < 8; ++nd) o[nd] = (f32x4){0.f, 0.f, 0.f, 0.f};
    const int kx = ((quad & 1) << 2) | (l16 >> 2);
    const LAS unsigned char* vb = Vl + (4 * quad + (l16 >> 2)) * 256 + 8 * (l16 & 3);
    const int w2 = w >> 1;
#pragma unroll
    for (int k2 = 0; k2 < 8; ++k2) {
        if (!band || (k2 >= w2 && k2 <= w2 + 4)) {
#pragma unroll
            for (int nd = 0; nd < 8; ++nd) {
                const LAS unsigned char* p0 = vb + k2 * 32 * 256 + ((nd ^ kx) << 5);
                const s16x4 lo = __builtin_bit_cast(s16x4, __builtin_amdgcn_ds_read_tr16_b64_v4i16((LAS s16x4*)p0));
                const s16x4 hi = __builtin_bit_cast(s16x4, __builtin_amdgcn_ds_read_tr16_b64_v4i16((LAS s16x4*)(p0 + 16 * 256)));
                const bf16x8 vf = {lo[0], lo[1], lo[2], lo[3], hi[0], hi[1], hi[2], hi[3]};
                o[nd] = __builtin_amdgcn_mfma_f32_16x16x32_bf16(vf, pf[k2], o[nd], 0, 0, 0);
            }
        }
    }
    if (qi < d.nvalid) {
        const float inv = 1.f / lsum;
        bf16_t* op = d.O + (long)qi * d.os + 4 * quad;
#pragma unroll
        for (int nd = 0; nd < 8; ++nd) { u32x2 t; t.x = pk2(o[nd][0] * inv, o[nd][1] * inv); t.y = pk2(o[nd][2] * inv, o[nd][3] * inv); *(u32x2*)(op + 16 * nd) = t; }
        if (d.L2 && quad == 0) d.L2[(long)qi * d.ls] = mx + __builtin_amdgcn_logf(lsum);
    }
}

__device__ __forceinline__ AttnDesc dil_prompt_desc(const Args& a, int it) {
    const int idx32 = it & 31, h = (it >> 5) & 3, g = (it >> 7) % 3, b = it / 384;
    const int rs = 2 * g, r = 1 << rs, nblk = 32 >> rs;
    const int c = idx32 / nblk, blk = idx32 % nblk;
    const bf16_t* P = (const bf16_t*)(a.ws + WS_PROJ);
    AttnDesc d;
    const long row_q0 = (long)b * SEQ + (long)blk * 128 * r + c;
    d.Q = P + row_q0 * NIN_A + g * 512 + h * 128; d.qs = (long)r * NIN_A;
    const long row_k0 = row_q0 - (long)128 * r;
    d.K = P + row_k0 * NIN_A + 1536 + g * 512 + h * 128; d.V = P + row_k0 * NIN_A + 3072 + g * 512 + h * 128; d.ks = (long)r * NIN_A;
    d.jmin = blk == 0 ? 128 : 0; d.band = 1; d.gq = nullptr; d.Kf = nullptr; d.Vf = nullptr;
    d.O = (bf16_t*)(a.ws + WS_OG) + (size_t)g * MT * 512 + row_q0 * 512 + h * 128; d.os = (long)r * 512;
    d.L2 = (float*)(a.ws + WS_L2G) + (size_t)g * MT * 4 + row_q0 * 4 + h; d.ls = (long)r * 4; d.nvalid = 128;
    return d;
}
__device__ __forceinline__ AttnDesc cross_desc(const Args& a, int layer, int it) {
    AttnDesc d; d.jmin = 0; d.band = 0; d.gq = a.in[27] + layer * 128; d.L2 = nullptr; d.ls = 0; d.Kf = nullptr; d.Vf = nullptr;
    const bf16_t* P = layer == 0 ? (const bf16_t*)(a.ws + WS_PROJ) : (const bf16_t*)(a.ws + WS_PROJ1);
    const long pitch = layer == 0 ? NIN_A : DM; const int qcol = layer == 0 ? 4608 : 512;
    bf16_t* MG = (bf16_t*)(a.ws + WS_MERGED);
    d.qs = pitch; d.ks = DM; d.os = DM;
    if (it < 512) { const int h = it & 3, blk = (it >> 2) & 31, b = it >> 7; const long row0 = (long)b * SEQ + blk * 128;
        d.Q = P + row0 * pitch + qcol + h * 128;
        const bf16_t* kv = (const bf16_t*)(a.ws + WS_MKV) + ((size_t)layer * 1024 + b * 256) * DM;
        d.K = kv + h * 128; d.V = kv + 512 + h * 128; d.O = MG + row0 * DM + 512 + h * 128; d.nvalid = 128; }
    else { const int h = it & 3, b = (it - 512) >> 2; const long row0 = MP + b * DS;
        d.Q = P + row0 * pitch + qcol + h * 128;
        const float* kvf = a.in[5] + ((size_t)layer * DB + b) * 256 * DM;
        d.K = nullptr; d.V = nullptr; d.Kf = kvf + h * 128; d.Vf = kvf + 512 + h * 128; d.O = MG + row0 * DM + 512 + h * 128; d.nvalid = DS; }
    return d;
}

__device__ __forceinline__ void sample_dil_item(const Args& a, int wi, int lane) {
    const int kq = wi & 3, h = (wi >> 2) & 3, g = (wi >> 4) % 3, bt = wi / 48, b = bt >> 2, t = bt & 3;
    const int r = 1 << (2 * g), Lb = 128 * r;
    const float* cache = g == 0 ? a.in[2] : g == 1 ? a.in[3] : a.in[4];
    const float* swin = a.out + (g == 0 ? O_SW0 : g == 1 ? O_SW1 : O_SW2);
    const bf16_t* P = (const bf16_t*)(a.ws + WS_PROJ);
    const int rs = b * DS + t; const long row = MP + rs;
    const int hl = lane & 31, par = lane >> 5;
    float q[4]; { const u32x2 w = *(const u32x2*)(P + row * NIN_A + g * 512 + h * 128 + 4 * hl); q[0] = bflo(w.x); q[1] = bfhi(w.x); q[2] = bflo(w.y); q[3] = bfhi(w.y); }
    const size_t boff = (size_t)b * Lb * 1024 + h * 128 + 4 * hl;
    const float* cb = cache + boff; const float* nb = swin + boff - 4 * 1024;
    f32x4 kv[17], vv[17];
#pragma unroll
    for (int u = 0; u < 17; ++u) { const int j = min(kq * 32 + 2 * u + par, 128); const int idx = Lb + t - r * j;
        const float* p = (idx >= Lb ? nb : cb) + (size_t)idx * 1024; kv[u] = *(const f32x4*)p; vv[u] = *(const f32x4*)(p + 512); }
    float sc = NEGBIG;
#pragma unroll
    for (int u = 0; u < 17; ++u) {
        float part = (q[0] * kv[u][0] + q[1] * kv[u][1]) + (q[2] * kv[u][2] + q[3] * kv[u][3]);
        part += __shfl_xor(part, 1); part += __shfl_xor(part, 2); part += __shfl_xor(part, 4); part += __shfl_xor(part, 8); part += __shfl_xor(part, 16);
        const int jo = 2 * u + par;
        const bool valid = jo < 32 || (jo == 32 && kq == 3);
        if (valid && hl == u) sc = part;
    }
    const float mx = wave_max(sc);
    const float pe = __builtin_amdgcn_exp2f(sc - mx);
    const float lsum = wave_sum(pe);
    f32x4 o = {0.f, 0.f, 0.f, 0.f};
#pragma unroll
    for (int u = 0; u < 17; ++u) { const float pj = __shfl(pe, par * 32 + u); o += pj * vv[u]; }
#pragma unroll
    for (int e = 0; e < 4; ++e) o[e] += __shfl_xor(o[e], 32);
    const float inv = 1.f / lsum;
    const int part_id = g * 4 + kq;
    if (par == 0) *(f32x4*)((float*)(a.ws + WS_SOG) + ((size_t)part_id * MS + rs) * 512 + h * 128 + 4 * hl) = o * inv;
    if (lane == 0) ((float*)(a.ws + WS_SL2))[((size_t)part_id * MS + rs) * 4 + h] = mx + __builtin_amdgcn_logf(lsum);
}

__device__ __forceinline__ AttnDesc item_desc(const Args& a, int mode, int it) {
    if (mode == 0) { if (it < 1536) return dil_prompt_desc(a, it); return cross_desc(a, 0, it - 1536); }
    return cross_desc(a, 1, it);
}
__device__ __forceinline__ void attn_run(const Args& a, int mode, int NI, LAS unsigned char* lds) {
    const int G = gridDim.x;
    int it = blockIdx.x;
    if (it >= NI) return;
    u32x4 kr[8], vr[8];
    AttnDesc d = item_desc(a, mode, it);
    attn_load1(d.K, d.Kf, d.ks, d.jmin, kr);
    for (;;) {
        attn_stageK(kr, lds);
        attn_load1(d.V, d.Vf, d.ks, d.jmin, vr);
        bf16x8 qf[4]; attn_qload(d, qf);
        __syncthreads();
        const int nx = it + G; const bool has = nx < NI;
        const AttnDesc dn = item_desc(a, mode, has ? nx : it);
        attn_compute(d, qf, lds, has, dn, kr, vr);
        __syncthreads();
        if (!has) break;
        it = nx; d = item_desc(a, mode, it);
    }
}
__device__ __forceinline__ void phase_attn0(const Args& a, LAS unsigned char* lds) {
    const int G = gridDim.x, bx = blockIdx.x;
    constexpr int NI = 1536 + 640, NSI = DB * DS * 48;
    const int wave = threadIdx.x >> 6, lane = threadIdx.x & 63;
    if (bx & 1) win_share(a, 0, WCA);
    if (G == 256) {
        if (bx >= 128) { const int base = ((bx - 128) * 8 + wave) * 4; for (int k = 0; k < 4; ++k) sample_dil_item(a, base + k, lane); }
        else { const int base = 4096 + (bx * 8 + wave) * 2; for (int k = 0; k < 2; ++k) sample_dil_item(a, base + k, lane); }
    } else { for (int wi = bx * 8 + wave; wi < NSI; wi += G * 8) sample_dil_item(a, wi, lane); }
    attn_run(a, 0, NI, lds);
    if (!(bx & 1)) win_share(a, 0, WCA);
}
__device__ __forceinline__ void phase_combine(const Args& a) {
    const size_t gtid = (size_t)blockIdx.x * 512 + threadIdx.x, nth = (size_t)gridDim.x * 512;
    const float* L2 = (const float*)(a.ws + WS_L2G); const bf16_t* OG = (const bf16_t*)(a.ws + WS_OG); bf16_t* MG = (bf16_t*)(a.ws + WS_MERGED);
    for (size_t it = gtid; it < (size_t)MP * 64; it += nth) { const size_t row = it >> 6; const int ch = (int)(it & 63), h = ch >> 4;
        const float l0 = L2[row * 4 + h], l1 = L2[(size_t)MT * 4 + row * 4 + h], l2 = L2[(size_t)2 * MT * 4 + row * 4 + h];
        const float mx = fmaxf(l0, fmaxf(l1, l2));
        float w0 = __builtin_amdgcn_exp2f(l0 - mx), w1 = __builtin_amdgcn_exp2f(l1 - mx), w2 = __builtin_amdgcn_exp2f(l2 - mx);
        const float inv = 1.f / (w0 + w1 + w2); w0 *= inv; w1 *= inv; w2 *= inv;
        const u32x4 a0 = *(const u32x4*)(OG + row * 512 + ch * 8), a1 = *(const u32x4*)(OG + (size_t)MT * 512 + row * 512 + ch * 8), a2 = *(const u32x4*)(OG + (size_t)2 * MT * 512 + row * 512 + ch * 8);
        u32x4 o;
        o.x = pk2(w0 * bflo(a0.x) + w1 * bflo(a1.x) + w2 * bflo(a2.x), w0 * bfhi(a0.x) + w1 * bfhi(a1.x) + w2 * bfhi(a2.x));
        o.y = pk2(w0 * bflo(a0.y) + w1 * bflo(a1.y) + w2 * bflo(a2.y), w0 * bfhi(a0.y) + w1 * bfhi(a1.y) + w2 * bfhi(a2.y));
        o.z = pk2(w0 * bflo(a0.z) + w1 * bflo(a1.z) + w2 * bflo(a2.z), w0 * bfhi(a0.z) + w1 * bfhi(a1.z) + w2 * bfhi(a2.z));
        o.w = pk2(w0 * bflo(a0.w) + w1 * bflo(a1.w) + w2 * bflo(a2.w), w0 * bfhi(a0.w) + w1 * bfhi(a1.w) + w2 * bfhi(a2.w));
        *(u32x4*)(MG + row * DM + ch * 8) = o; }
    const float* SL2 = (const float*)(a.ws + WS_SL2); const float* SOG = (const float*)(a.ws + WS_SOG);
    for (size_t it = gtid; it < (size_t)MS * 64; it += nth) { const int rs = (int)(it >> 6), ch = (int)(it & 63), h = ch >> 4;
        float l[12]; float mx = NEGBIG;
#pragma unroll
        for (int p = 0; p < 12; ++p) { l[p] = SL2[((size_t)p * MS + rs) * 4 + h]; mx = fmaxf(mx, l[p]); }
        float ws = 0.f;
#pragma unroll
        for (int p = 0; p < 12; ++p) { l[p] = __builtin_amdgcn_exp2f(l[p] - mx); ws += l[p]; }
        const float inv = 1.f / ws;
        f32x4 o0 = {0.f, 0.f, 0.f, 0.f}, o1 = {0.f, 0.f, 0.f, 0.f};
#pragma unroll
        for (int p = 0; p < 12; ++p) { const float* s = SOG + ((size_t)p * MS + rs) * 512 + ch * 8; o0 += l[p] * *(const f32x4*)s; o1 += l[p] * *(const f32x4*)(s + 4); }
        o0 *= inv; o1 *= inv;
        u32x4 o; o.x = pk2(o0[0], o0[1]); o.y = pk2(o0[2], o0[3]); o.z = pk2(o1[0], o1[1]); o.w = pk2(o1[2], o1[3]);
        *(u32x4*)(MG + ((size_t)MP + rs) * DM + ch * 8) = o; }
}

__device__ __forceinline__ void conv_rows(const float (&wa)[3][8], const float (&wb)[3][8], const float (&ba)[8], const float (&bb)[8],
                                          float (&a2)[8], float (&a1)[8], float (&b2)[8], float (&b1)[8], const float (&ac)[8], const float (&bc)[8], bf16_t* dst) {
    float o[8];
#pragma unroll
    for (int e = 0; e < 8; ++e) { const float A = ba[e] + wa[0][e] * a2[e] + wa[1][e] * a1[e] + wa[2][e] * ac[e]; const float B = bb[e] + wb[0][e] * b2[e] + wb[1][e] * b1[e] + wb[2][e] * bc[e];
        o[e] = A * __builtin_amdgcn_rcpf(1.f + __expf(-A)) * B; a2[e] = a1[e]; a1[e] = ac[e]; b2[e] = b1[e]; b1[e] = bc[e]; }
    u32x4 w; w.x = pk2(o[0], o[1]); w.y = pk2(o[2], o[3]); w.z = pk2(o[4], o[5]); w.w = pk2(o[6], o[7]);
    *(u32x4*)dst = w;
}
__device__ __forceinline__ void phase_conv_fix(const Args& a, int layer) {
    const size_t gtid = (size_t)blockIdx.x * 512 + threadIdx.x, nth = (size_t)gridDim.x * 512;
    const bf16_t* BND = (const bf16_t*)(a.ws + WS_BND); const bf16_t* UPS = (const bf16_t*)(a.ws + WS_UPS); bf16_t* ACT = (bf16_t*)(a.ws + WS_ACT);
    const float* cw = a.in[31] + (size_t)layer * 3 * NUP; const float* cb = a.in[32] + (size_t)layer * NUP;
    constexpr int NCC = DFF / 8;
    for (size_t it = gtid; it < (size_t)(256 + DB) * NCC; it += nth) {
        const int cc = (int)(it % NCC), k = (int)(it / NCC), col = cc * 8;
        if (k < 256 && (k & 63) == 0) continue;
        float wa[3][8], wb[3][8], ba[8], bb[8];
#pragma unroll
        for (int j = 0; j < 3; ++j) { load8f(cw + j * NUP + col, wa[j]); load8f(cw + j * NUP + DFF + col, wb[j]); }
        load8f(cb + col, ba); load8f(cb + DFF + col, bb);
        float a2[8], a1[8], b2[8], b1[8], ac[8], bc[8];
        if (k < 256) {
            const bf16_t* pv = BND + (size_t)(k - 1) * 4 * NUP; const bf16_t* cu = BND + (size_t)k * 4 * NUP;
            unpack8(*(const u32x4*)(pv + (size_t)(2 * 2 + 0) * DFF + col), a2); unpack8(*(const u32x4*)(pv + (size_t)(2 * 2 + 1) * DFF + col), b2);
            unpack8(*(const u32x4*)(pv + (size_t)(3 * 2 + 0) * DFF + col), a1); unpack8(*(const u32x4*)(pv + (size_t)(3 * 2 + 1) * DFF + col), b1);
            unpack8(*(const u32x4*)(cu + (size_t)(0 * 2 + 0) * DFF + col), ac); unpack8(*(const u32x4*)(cu + (size_t)(0 * 2 + 1) * DFF + col), bc);
            conv_rows(wa, wb, ba, bb, a2, a1, b2, b1, ac, bc, ACT + (size_t)(64 * k) * DFF + col);
            unpack8(*(const u32x4*)(cu + (size_t)(1 * 2 + 0) * DFF + col), ac); unpack8(*(const u32x4*)(cu + (size_t)(1 * 2 + 1) * DFF + col), bc);
            conv_rows(wa, wb, ba, bb, a2, a1, b2, b1, ac, bc, ACT + (size_t)(64 * k + 1) * DFF + col);
        } else {
            const int b = k - 256;
            const float* st = a.in[7] + ((size_t)layer * DB + b) * 2 * NUP;
            load8f(st + col, a2); load8f(st + NUP + col, a1); load8f(st + DFF + col, b2); load8f(st + NUP + DFF + col, b1);
#pragma unroll
            for (int t = 0; t < DS; ++t) { const bf16_t* r = UPS + (size_t)(b * DS + t) * NUP;
                unpack8(*(const u32x4*)(r + col), ac); unpack8(*(const u32x4*)(r + DFF + col), bc);
                conv_rows(wa, wb, ba, bb, a2, a1, b2, b1, ac, bc, ACT + (size_t)(MP + b * DS + t) * DFF + col); }
        }
    }
    constexpr int NC8 = NUP / 8;
    for (size_t it = gtid; it < (size_t)(NB + DB) * 2 * NC8; it += nth) {
        const int c8 = (int)(it % NC8), rr = (int)((it / NC8) & 1), sb = (int)(it / (2 * NC8));
        const bf16_t* srcp; float* dst;
        if (sb < NB) { srcp = BND + ((size_t)(sb * 64 + 63) * 4 + 2 + rr) * NUP + c8 * 8; dst = a.out + O_PCONV + (((size_t)layer * NB + sb) * 2 + rr) * NUP + c8 * 8; }
        else { const int b = sb - NB; srcp = UPS + (size_t)(b * DS + 2 + rr) * NUP + c8 * 8; dst = a.out + O_SCONV + (((size_t)layer * DB + b) * 2 + rr) * NUP + c8 * 8; }
        float x[8]; unpack8(*(const u32x4*)srcp, x);
        *(f32x4*)dst = (f32x4){x[0], x[1], x[2], x[3]}; *(f32x4*)(dst + 4) = (f32x4){x[4], x[5], x[6], x[7]};
    }
}

struct S5B { float lbr, lbi; bf16x8 bf[8], bl[8]; };
__device__ __forceinline__ void s5_lambda(float are, float aim, float dt, float& lbr, float& lbi) {
    const float mag = __expf(are * dt);
    float turns = aim * dt * 0.15915494309189535f; turns -= rintf(turns);
    lbr = mag * __builtin_amdgcn_cosf(turns); lbi = mag * __builtin_amdgcn_sinf(turns);
}
__device__ __forceinline__ void s5_consts(const Args& a, int G, int lane, S5B& c) {
    const int l16 = lane & 15, quad = lane >> 4;
    const float dt = __expf(a.in[17][G]);
    s5_lambda(a.in[15][G * 64 + lane], a.in[16][G * 64 + lane], dt, c.lbr, c.lbi);
#pragma unroll
    for (int q4 = 0; q4 < 4; ++q4) {
        const int p = 16 * q4 + l16;
        const float are = a.in[15][G * 64 + p], aim = a.in[16][G * 64 + p];
        float lr, li; s5_lambda(are, aim, dt, lr, li);
        const float den = are * are + aim * aim, xr = lr - 1.f, yi = li;
        const float fre = (xr * are + yi * aim) / den, fim = (yi * are - xr * aim) / den;
        u32x4 wr = {0u, 0u, 0u, 0u}, wi = {0u, 0u, 0u, 0u}, lr4 = {0u, 0u, 0u, 0u}, li4 = {0u, 0u, 0u, 0u};
        if (quad < 2) { float br[8], bi[8]; load8f(a.in[18] + (size_t)(G * 64 + p) * 16 + quad * 8, br); load8f(a.in[19] + (size_t)(G * 64 + p) * 16 + quad * 8, bi);
            float r[8], i[8];
#pragma unroll
            for (int e = 0; e < 8; ++e) { r[e] = fre * br[e] - fim * bi[e]; i[e] = fre * bi[e] + fim * br[e]; }
            wr.x = pk2(r[0], r[1]); wr.y = pk2(r[2], r[3]); wr.z = pk2(r[4], r[5]); wr.w = pk2(r[6], r[7]);
            wi.x = pk2(i[0], i[1]); wi.y = pk2(i[2], i[3]); wi.z = pk2(i[4], i[5]); wi.w = pk2(i[6], i[7]);
            float rh[8], ih[8]; unpack8(wr, rh); unpack8(wi, ih);
#pragma unroll
            for (int e = 0; e < 8; ++e) { r[e] -= rh[e]; i[e] -= ih[e]; }
            lr4.x = pk2(r[0], r[1]); lr4.y = pk2(r[2], r[3]); lr4.z = pk2(r[4], r[5]); lr4.w = pk2(r[6], r[7]);
            li4.x = pk2(i[0], i[1]); li4.y = pk2(i[2], i[3]); li4.z = pk2(i[4], i[5]); li4.w = pk2(i[6], i[7]); }
        c.bf[q4] = __builtin_bit_cast(bf16x8, wr); c.bf[4 + q4] = __builtin_bit_cast(bf16x8, wi);
        c.bl[q4] = __builtin_bit_cast(bf16x8, lr4); c.bl[4 + q4] = __builtin_bit_cast(bf16x8, li4);
    }
}
__device__ __forceinline__ void s5_bu16(const S5B& c, const LAS bf16_t* ub, int sub, LAS float* bul, int lane) {
    const int l16 = lane & 15, quad = lane >> 4;
    u32x4 aw = {0u, 0u, 0u, 0u};
    if (quad < 2) aw = *(const LAS u32x4*)(ub + (sub * 16 + l16) * 16 + quad * 8);
    const bf16x8 af = __builtin_bit_cast(bf16x8, aw);
    f32x4 d[8];
#pragma unroll
    for (int nt = 0; nt < 8; ++nt) { d[nt] = __builtin_amdgcn_mfma_f32_16x16x32_bf16(af, c.bl[nt], (f32x4){0.f, 0.f, 0.f, 0.f}, 0, 0, 0); d[nt] = __builtin_amdgcn_mfma_f32_16x16x32_bf16(af, c.bf[nt], d[nt], 0, 0, 0); }
    asm volatile("s_nop 15\n\ts_nop 15" : "+v"(d[0]), "+v"(d[1]), "+v"(d[2]), "+v"(d[3]), "+v"(d[4]), "+v"(d[5]), "+v"(d[6]), "+v"(d[7]));
#pragma unroll
    for (int nt = 0; nt < 8; ++nt)
#pragma unroll
        for (int j = 0; j < 4; ++j) bul[(quad * 4 + j) * 132 + 16 * nt + l16] = d[nt][j];
    LDS_WAIT();
}
__device__ __forceinline__ void s5_stage_u(const bf16_t* up, int nst, LAS bf16_t* ub, int lane) {
    u32x4 w0 = {0u, 0u, 0u, 0u}, w1 = {0u, 0u, 0u, 0u};
    if (lane < nst) { w0 = *(const u32x4*)(up + (size_t)lane * DM); w1 = *(const u32x4*)(up + (size_t)lane * DM + 8); }
    *(LAS u32x4*)(ub + lane * 16) = w0; *(LAS u32x4*)(ub + lane * 16 + 8) = w1;
    LDS_WAIT();
}
__device__ __forceinline__ void phase_s5_pass1(const Args& a, LAS unsigned char* lds) {
    const int lane = threadIdx.x & 63, wave = threadIdx.x >> 6;
    const int gw = blockIdx.x * 8 + wave, NGW = gridDim.x * 8;
    const bf16_t* P1 = (const bf16_t*)(a.ws + WS_PROJ1); f32x2* E = (f32x2*)(a.ws + WS_E);
    LAS bf16_t* ub = (LAS bf16_t*)(lds + wave * 16384 + 4608);
    LAS float* bul = (LAS float*)(lds + wave * 16384 + 6656);
    for (int wi = gw; wi < NB * 63 * 32; wi += NGW) {
        const int G = wi & 31, ch = (wi >> 5) % 63, b = (wi >> 5) / 63;
        s5_stage_u(P1 + ((size_t)b * SEQ + ch * 64) * DM + G * 16, 64, ub, lane);
        S5B c; s5_consts(a, G, lane, c);
        float sr = 0.f, si = 0.f;
        for (int sub = 0; sub < 4; ++sub) {
            s5_bu16(c, ub, sub, bul, lane);
#pragma unroll
            for (int tl = 0; tl < 16; ++tl) { const float br = bul[tl * 132 + lane], bi = bul[tl * 132 + 64 + lane];
                const float nr = c.lbr * sr - c.lbi * si + br, ni = c.lbr * si + c.lbi * sr + bi; sr = nr; si = ni; }
            LDS_WAIT();
        }
        E[(((size_t)b * 64 + ch) * 32 + G) * 64 + lane] = (f32x2){sr, si};
    }
}
__device__ __forceinline__ void phase_s5_pass2(const Args& a, LAS unsigned char* lds) {
    const int lane = threadIdx.x & 63, wave = threadIdx.x >> 6, l16 = lane & 15, quad = lane >> 4;
    const int gw = blockIdx.x * 8 + wave, NGW = gridDim.x * 8;
    const bf16_t* P1 = (const bf16_t*)(a.ws + WS_PROJ1); const f32x2* E = (const f32x2*)(a.ws + WS_E); bf16_t* Y = (bf16_t*)(a.ws + WS_Y);
    LAS bf16_t* st = (LAS bf16_t*)(lds + wave * 16384);
    LAS bf16_t* ub = (LAS bf16_t*)(lds + wave * 16384 + 4608);
    LAS float* bul = (LAS float*)(lds + wave * 16384 + 6656);
    for (int wi = gw; wi < NB * 64 * 32 + DB * 32; wi += NGW) {
        const bool prompt = wi < NB * 64 * 32;
        int G, ch, b; size_t row0;
        if (prompt) { G = wi & 31; ch = (wi >> 5) & 63; b = wi >> 11; row0 = (size_t)b * SEQ + ch * 64; }
        else { const int x = wi - NB * 64 * 32; G = x & 31; b = x >> 5; ch = 0; row0 = (size_t)MP + b * DS; }
        const int nsub = prompt ? 4 : 1, nst = prompt ? 16 : DS;
        s5_stage_u(P1 + row0 * DM + G * 16, prompt ? 64 : DS, ub, lane);
        S5B c; s5_consts(a, G, lane, c);
        float sr, si;
        if (prompt) {
            float pr = c.lbr, pi = c.lbi;
#pragma unroll
            for (int q = 0; q < 6; ++q) { const float nr = pr * pr - pi * pi, ni = 2.f * pr * pi; pr = nr; pi = ni; }
            sr = 0.f; si = 0.f;
            const f32x2* Eb = E + (((size_t)b * 64) * 32 + G) * 64 + lane;
            int j = 0;
            for (; j + 16 <= ch; j += 16) { f32x2 e[16];
#pragma unroll
                for (int u = 0; u < 16; ++u) e[u] = Eb[(size_t)(j + u) * 2048];
#pragma unroll
                for (int u = 0; u < 16; ++u) { const float nr = pr * sr - pi * si + e[u][0], ni = pr * si + pi * sr + e[u][1]; sr = nr; si = ni; } }
            for (; j + 8 <= ch; j += 8) { f32x2 e[8];
#pragma unroll
                for (int u = 0; u < 8; ++u) e[u] = Eb[(size_t)(j + u) * 2048];
#pragma unroll
                for (int u = 0; u < 8; ++u) { const float nr = pr * sr - pi * si + e[u][0], ni = pr * si + pi * sr + e[u][1]; sr = nr; si = ni; } }
            for (; j < ch; ++j) { const f32x2 e = Eb[(size_t)j * 2048]; const float nr = pr * sr - pi * si + e[0], ni = pr * si + pi * sr + e[1]; sr = nr; si = ni; }
        } else { sr = a.in[6][(((size_t)b * 2 + 0) * 32 + G) * 64 + lane]; si = a.in[6][(((size_t)b * 2 + 1) * 32 + G) * 64 + lane]; }
        bf16x8 cf[4];
#pragma unroll
        for (int ks = 0; ks < 4; ++ks) { const int k0 = ks * 32 + quad * 8; float v[8];
            if (k0 < 64) load8f(a.in[20] + (size_t)(G * 16 + l16) * 64 + k0, v);
            else { load8f(a.in[21] + (size_t)(G * 16 + l16) * 64 + (k0 - 64), v);
#pragma unroll
                for (int e = 0; e < 8; ++e) v[e] = -v[e]; }
            u32x4 t; t.x = pk2(v[0], v[1]); t.y = pk2(v[2], v[3]); t.z = pk2(v[4], v[5]); t.w = pk2(v[6], v[7]); cf[ks] = __builtin_bit_cast(bf16x8, t); }
        const float dsk = a.in[22][G * 16 + l16];
        for (int sub = 0; sub < nsub; ++sub) {
            const size_t rbase = row0 + sub * 16;
            s5_bu16(c, ub, sub, bul, lane);
#pragma unroll 4
            for (int tl = 0; tl < nst; ++tl) {
                const float br = bul[tl * 132 + lane], bi = bul[tl * 132 + 64 + lane];
                const float nr = c.lbr * sr - c.lbi * si + br, ni = c.lbr * si + c.lbi * sr + bi; sr = nr; si = ni;
                st[tl * 136 + lane] = f2bf(sr); st[tl * 136 + 64 + lane] = f2bf(si);
            }
            LDS_WAIT();
            f32x4 acc = {0.f, 0.f, 0.f, 0.f};
#pragma unroll
            for (int ks = 0; ks < 4; ++ks) { const bf16x8 af = *(const LAS bf16x8*)(st + l16 * 136 + ks * 32 + quad * 8);
                acc = __builtin_amdgcn_mfma_f32_16x16x32_bf16(af, cf[ks], acc, 0, 0, 0); }
#pragma unroll
            for (int j = 0; j < 4; ++j) { const int t = quad * 4 + j;
                if (t < nst) { const size_t row = rbase + t;
                    const float uval = bf2f(ub[(sub * 16 + t) * 16 + l16]);
                    const float y = acc[j] + dsk * uval;
                    const float z2 = 1.5957691216057308f * (y + 0.044715f * y * y * y);
                    Y[row * 512 + G * 16 + l16] = f2bf(y * __builtin_amdgcn_rcpf(1.f + __expf(-z2))); } }
            LDS_WAIT();
        }
        if (prompt) { if (ch == 63) { a.out[O_PS5 + (((size_t)b * 2 + 0) * 32 + G) * 64 + lane] = sr; a.out[O_PS5 + (((size_t)b * 2 + 1) * 32 + G) * 64 + lane] = si; } }
        else { a.out[O_SS5 + (((size_t)b * 2 + 0) * 32 + G) * 64 + lane] = sr; a.out[O_SS5 + (((size_t)b * 2 + 1) * 32 + G) * 64 + lane] = si; }
    }
}

#define XB_TMO      128
#define XB_XCNT(j)  (256  + 64 * (j))
#define XB_XSUB(j)  (1280 + 64 * (j))
#define XB_XGEN(j)  (2304 + 64 * (j))
#define XB_TOP      3328
#define XB_TOPGEN   3392
#define XCD_BAR_WORDS 3456
#define XB_SPIN_CAP (1u << 18)

__device__ __forceinline__ unsigned xb_ld(unsigned* p)              { return __hip_atomic_load(p, __ATOMIC_RELAXED, __HIP_MEMORY_SCOPE_AGENT); }
__device__ __forceinline__ unsigned xb_add(unsigned* p, unsigned v) { return __hip_atomic_fetch_add(p, v, __ATOMIC_RELAXED, __HIP_MEMORY_SCOPE_AGENT); }
__device__ __forceinline__ unsigned xb_xcc_id() { return (unsigned)__builtin_amdgcn_s_getreg((3 << 11) | 20) & 0xFu; }
#define XB_SPIN(cond, bar) do { unsigned _sp = 0; while (cond) { __builtin_amdgcn_s_sleep(16); \
    if ((++_sp & 255u) == 0u) { if (xb_ld(&(bar)[XB_TMO])) break; if (_sp > XB_SPIN_CAP) { atomicAdd(&(bar)[XB_TMO], 1u); break; } } } } while (0)

struct XcdBarrier {
    unsigned* bar; unsigned x;
    volatile LAS unsigned* st;
};

__device__ __forceinline__ XcdBarrier xcd_barrier_post(unsigned* bar, volatile LAS unsigned* st) {
    XcdBarrier b; b.bar = bar; b.x = xb_xcc_id(); b.st = st;
    if (threadIdx.x == 0) (void)xb_add(&bar[XB_XCNT(b.x)], 1u);
    return b;
}
__device__ __forceinline__ void xcd_barrier_complete(unsigned* bar, unsigned x, unsigned& nloc, unsigned& nx) {
    const unsigned G = gridDim.x * gridDim.y * gridDim.z;
    unsigned sum, cnt, mine, sp = 0u;
    for (;;) {
        sum = 0u; cnt = 0u; mine = 0u;
#pragma unroll
        for (unsigned j = 0; j < 16; ++j) { const unsigned c = xb_ld(&bar[XB_XCNT(j)]); sum += c; cnt += (c > 0u) ? 1u : 0u; mine = (j == x) ? c : mine; }
        if (sum == G) break;
        __builtin_amdgcn_s_sleep(1);
        if ((++sp & 255u) == 0u) { if (xb_ld(&bar[XB_TMO])) break; if (sp > XB_SPIN_CAP) { atomicAdd(&bar[XB_TMO], 1u); break; } }
    }
    nloc = mine > 0u ? mine : 1u; nx = cnt > 0u ? cnt : 1u;
}

__device__ __forceinline__ void xcd_barrier(const XcdBarrier& b) {
    asm volatile("s_waitcnt vmcnt(0)" ::: "memory");
    __syncthreads();
    if (threadIdx.x == 0) {
        unsigned* bar = b.bar;
        __builtin_amdgcn_s_waitcnt(0);
        unsigned nloc = b.st[0], nx = b.st[1];
        if (nloc == 0u) { xcd_barrier_complete(bar, b.x, nloc, nx); b.st[0] = nloc; b.st[1] = nx; }
        const unsigned old = xb_add(&bar[XB_XSUB(b.x)], 1u);
        const unsigned gen = old / nloc;
        if (old + 1u == (gen + 1u) * nloc) {
            __builtin_amdgcn_fence(__ATOMIC_RELEASE, "agent");
            asm volatile("s_waitcnt vmcnt(0)" ::: "memory");
            const unsigned og = xb_add(&bar[XB_TOP], 1u);
            const unsigned tg = og / nx;
            if (og + 1u == (tg + 1u) * nx) xb_add(&bar[XB_TOPGEN], 1u);
            else XB_SPIN(xb_ld(&bar[XB_TOPGEN]) == tg, bar);
            __builtin_amdgcn_fence(__ATOMIC_ACQUIRE, "agent");
            xb_add(&bar[XB_XGEN(b.x)], 1u);
            asm volatile("s_waitcnt vmcnt(0)" ::: "memory");
        } else {
            XB_SPIN(xb_ld(&bar[XB_XGEN(b.x)]) == gen, bar);
            __builtin_amdgcn_fence(__ATOMIC_ACQUIRE, "agent");
            asm volatile("s_waitcnt vmcnt(0)" ::: "memory");
        }
    }
    __syncthreads();
}

constexpr int NPHASE = 17;
#define GEMM_CALL(EpiT, gdesc, sched, epi) pg8::gemm_phase<EpiT, pg8::StaticOrder, true, true>(lds, gdesc, sched, epi)

__global__ void __launch_bounds__(512, 2) trunk_fwd(Args a) {
    extern __shared__ __attribute__((aligned(16))) unsigned char lds_raw[];
    LAS unsigned char* lds = (LAS unsigned char*)lds_raw;
    cg::grid_group grid = cg::this_grid();
    const int lo = a.ph_lo, hi = a.ph_hi;
    const int G = gridDim.x, bx = blockIdx.x;
    const int wave = threadIdx.x >> 6, lane = threadIdx.x & 63;
    const int gw = bx * 8 + wave, NGW = G * 8;
    unsigned char* ws = a.ws;
    bf16_t* HB = (bf16_t*)(ws + WS_HB);
    float* SUMSQ = (float*)(ws + WS_SUMSQ);
    float* X = (float*)(ws + WS_X);
#define IN(k) (lo <= (k) && (k) < hi)
    volatile LAS unsigned* bst = (volatile LAS unsigned*)(lds + 131072);
    if (threadIdx.x < 2) bst[threadIdx.x] = 0u;
    __syncthreads();
    XcdBarrier xbar = xcd_barrier_post((unsigned*)(ws + WS_BAR), bst);
    if (lo < 0) grid.sync();
#define SEAM(k) do { if (IN(k) && IN((k) + 1)) xcd_barrier(xbar); } while (0)

    if (IN(0)) { phase_prep(a, lds); __syncthreads(); }
    SEAM(0);
    if (IN(1)) {
        { pg8::Gemm g{HB, (const bf16_t*)(ws + WS_WINA), MP, NIN_A, DM}; pg8::StaticOrder S; S.init(MP, NIN_A, G, bx);
          EpiStoreBf16 E{(bf16_t*)(ws + WS_PROJ), NIN_A, nullptr}; GEMM_CALL(EpiStoreBf16, g, S, E); }
        { SkStore F{(bf16_t*)(ws + WS_PROJ), NIN_A, nullptr}; skinny_gemm(HB, (const bf16_t*)(ws + WS_WINA), DM, NIN_A, F); }
        win_idle(a, WCC, WCD, 32);
        for (int i = 0; i < 2; ++i) {
            pg8::Gemm g{(const bf16_t*)(ws + WS_MEMN) + (size_t)i * DM * DM, (const bf16_t*)(ws + WS_WMKV) + (size_t)i * DM * DM, 1024, 1024, DM};
            pg8::StaticOrder S; S.init(1024, 1024, G, (bx + 2 * G - 16 * i) % G);
            EpiStoreBf16 E{(bf16_t*)(ws + WS_MKVR) + (size_t)i * DM * DM, DM, nullptr}; GEMM_CALL(EpiStoreBf16, g, S, E); }
    }
    SEAM(1);
    if (IN(2)) {
        for (int m = gw; m < MT + 2048; m += NGW) { if (m < MT) p2_row(a, m, lane); else p2_memrow(a, m - MT, lane); }
    }
    SEAM(2);
    if (IN(3)) phase_attn0(a, lds);
    SEAM(3);
    if (IN(4)) phase_combine(a);
    SEAM(4);
    if (IN(5)) {
        pg8::Gemm g{(const bf16_t*)(ws + WS_MERGED), (const bf16_t*)(ws + WS_WOUT), MP, DM, DM}; pg8::StaticOrder S; S.init(MP, DM, G, bx);
        EpiResidual E{a.in[0], a.in[1], X, X + (size_t)MP * DM, SUMSQ, HB, a.in[10]}; GEMM_CALL(EpiResidual, g, S, E);
        SkResidual F{a.in[1], X + (size_t)MP * DM, SUMSQ, HB, a.in[10]}; skinny_gemm_splitk((const bf16_t*)(ws + WS_MERGED), (const bf16_t*)(ws + WS_WOUT), DM, DM, F, lds); }
    SEAM(5);
    if (IN(6)) {
        pg8::Gemm g{HB, (const bf16_t*)(ws + WS_WUP), MPAD, NUP, DM}; pg8::StaticOrder S; S.init(MPAD, NUP, G, bx);
        EpiUpConv E{(bf16_t*)(ws + WS_ACT), SUMSQ, a.in[31], a.in[32], (bf16_t*)(ws + WS_BND), (bf16_t*)(ws + WS_UPS)}; GEMM_CALL(EpiUpConv, g, S, E);
        win_idle(a, WCD, WCE, (MPAD / 256) * (NUP / 256) % G); }
    SEAM(6);
    if (IN(7)) phase_conv_fix(a, 0);
    SEAM(7);
    if (IN(8)) {
        pg8::Gemm g{(const bf16_t*)(ws + WS_ACT), (const bf16_t*)(ws + WS_WDN), MP, DM, DFF}; pg8::StaticOrder S; S.init(MP, DM, G, bx);
        EpiResidual E{X, X + (size_t)MP * DM, X, X + (size_t)MP * DM, SUMSQ + MPAD, HB, a.in[9] + DM}; GEMM_CALL(EpiResidual, g, S, E);
        SkResidual F{X + (size_t)MP * DM, X + (size_t)MP * DM, SUMSQ + MPAD, HB, a.in[9] + DM}; skinny_gemm_splitk((const bf16_t*)(ws + WS_ACT), (const bf16_t*)(ws + WS_WDN), DFF, DM, F, lds); }
    SEAM(8);
    if (IN(9)) {
        pg8::Gemm g{HB, (const bf16_t*)(ws + WS_WINB), MP, DM, DM}; pg8::StaticOrder S; S.init(MP, DM, G, bx);
        EpiStoreBf16 E{(bf16_t*)(ws + WS_PROJ1), DM, SUMSQ + MPAD}; GEMM_CALL(EpiStoreBf16, g, S, E);
        SkStore F{(bf16_t*)(ws + WS_PROJ1), DM, SUMSQ + MPAD}; skinny_gemm_splitk(HB, (const bf16_t*)(ws + WS_WINB), DM, DM, F, lds); }
    SEAM(9);
    if (IN(10)) {
        if (bx & 1) win_share(a, WCA, WCB);
        attn_run(a, 1, 640, lds);
        phase_s5_pass1(a, lds);
        if (!(bx & 1)) win_share(a, WCA, WCB);
    }
    SEAM(10);
    if (IN(11)) { if (bx & 1) win_share(a, WCB, WCC); phase_s5_pass2(a, lds); __syncthreads(); if (!(bx & 1)) win_share(a, WCB, WCC); }
    SEAM(11);
    if (IN(12)) {
        pg8::Gemm g{(const bf16_t*)(ws + WS_Y), (const bf16_t*)(ws + WS_WGLU), MP, 512, 512}; pg8::StaticOrder S; S.init(MP, 512, G, bx);
        EpiGlu E{(bf16_t*)(ws + WS_MERGED), DM, (const bf16_t*)(ws + WS_Y), a.in[24]}; GEMM_CALL(EpiGlu, g, S, E);
        SkGlu F{(bf16_t*)(ws + WS_MERGED), DM, (const bf16_t*)(ws + WS_Y), a.in[24]}; skinny_gemm_splitk((const bf16_t*)(ws + WS_Y), (const bf16_t*)(ws + WS_WGLU), 512, 512, F, lds);
        if (bx >= 128 && G > 128) win_copy<2048>(a.in[4], a.out + O_SW2, W2_A, W2_B, (size_t)(bx - 128) * 512 + threadIdx.x, (size_t)(G - 128) * 512); }
    SEAM(12);
    if (IN(13)) {
        pg8::Gemm g{(const bf16_t*)(ws + WS_MERGED), (const bf16_t*)(ws + WS_WOUT) + (size_t)DM * DM, MP, DM, DM}; pg8::StaticOrder S; S.init(MP, DM, G, bx);
        EpiResidual E{X, X + (size_t)MP * DM, X, X + (size_t)MP * DM, SUMSQ + 2 * MPAD, HB, a.in[10] + DM}; GEMM_CALL(EpiResidual, g, S, E);
        SkResidual F{X + (size_t)MP * DM, X + (size_t)MP * DM, SUMSQ + 2 * MPAD, HB, a.in[10] + DM}; skinny_gemm_splitk((const bf16_t*)(ws + WS_MERGED), (const bf16_t*)(ws + WS_WOUT) + (size_t)DM * DM, DM, DM, F, lds); }
    SEAM(13);
    if (IN(14)) {
        pg8::Gemm g{HB, (const bf16_t*)(ws + WS_WUP) + (size_t)NUP * DM, MPAD, NUP, DM}; pg8::StaticOrder S; S.init(MPAD, NUP, G, bx);
        EpiUpConv E{(bf16_t*)(ws + WS_ACT), SUMSQ + 2 * MPAD, a.in[31] + (size_t)3 * NUP, a.in[32] + NUP, (bf16_t*)(ws + WS_BND), (bf16_t*)(ws + WS_UPS)}; GEMM_CALL(EpiUpConv, g, S, E);
        win_idle(a, WCE, WCT, (MPAD / 256) * (NUP / 256) % G); }
    SEAM(14);
    if (IN(15)) phase_conv_fix(a, 1);
    SEAM(15);
    if (IN(16)) {
        pg8::Gemm g{(const bf16_t*)(ws + WS_ACT), (const bf16_t*)(ws + WS_WDN) + (size_t)DM * DFF, MP, DM, DFF}; pg8::StaticOrder S; S.init(MP, DM, G, bx);
        EpiResidual E{X, X + (size_t)MP * DM, a.out + O_YP, a.out + O_YS, nullptr, nullptr, nullptr}; GEMM_CALL(EpiResidual, g, S, E);
        SkResidual F{X + (size_t)MP * DM, a.out + O_YS, nullptr, nullptr, nullptr}; skinny_gemm_splitk((const bf16_t*)(ws + WS_ACT), (const bf16_t*)(ws + WS_WDN) + (size_t)DM * DFF, DFF, DM, F, lds); }
#undef IN
#undef SEAM
}

extern "C" void kernel_launch(void* const* d_in, const int* in_sizes, int n_in, void* d_out, int out_size, void* d_ws, size_t ws_size, hipStream_t stream) {
    static int grid = 0;
    if (grid == 0) {
        if (n_in != 34 || (size_t)out_size != O_END || ws_size < WS_END) { fprintf(stderr, "kernel_launch: unexpected shapes (n_in %d, out %d, ws %zu)\n", n_in, out_size, ws_size); grid = -1; return; }
        int dev = 0, cus = 0, per_cu = 0;
        if (hipGetDevice(&dev) != hipSuccess || hipDeviceGetAttribute(&cus, hipDeviceAttributeMultiprocessorCount, dev) != hipSuccess) { grid = -1; return; }
        if (hipFuncSetAttribute((const void*)trunk_fwd, hipFuncAttributeMaxDynamicSharedMemorySize, LDS_BYTES) != hipSuccess) { fprintf(stderr, "kernel_launch: hipFuncSetAttribute failed\n"); grid = -1; return; }
        if (hipOccupancyMaxActiveBlocksPerMultiprocessor(&per_cu, (const void*)trunk_fwd, 512, LDS_BYTES) != hipSuccess || per_cu < 1) { fprintf(stderr, "kernel_launch: occupancy query says %d\n", per_cu); grid = -1; (void)hipGetLastError(); return; }
        grid = cus * per_cu;
    }
    if (grid < 0) return;
    Args a{};
    for (int i = 0; i < 34; ++i) a.in[i] = (const float*)d_in[i];
    a.out = (float*)d_out; a.ws = (unsigned char*)d_ws;
#if MK_N_LAUNCHES == 1
    a.ph_lo = 0; a.ph_hi = NPHASE;
    if (hipMemsetAsync((char*)d_ws + WS_BAR, 0, 16384, stream) != hipSuccess) { fprintf(stderr, "kernel_launch: memset failed\n"); return; }
    void* args[] = {&a};
    hipError_t e = hipLaunchCooperativeKernel((const void*)trunk_fwd, dim3(grid), dim3(512), args, LDS_BYTES, stream);
    if (e != hipSuccess) fprintf(stderr, "kernel_launch: cooperative launch failed: %s (grid %d)\n", hipGetErrorString(e), grid);
#else
    for (int p = 0; p < NPHASE; ++p) { a.ph_lo = p; a.ph_hi = p + 1; hipLaunchKernelGGL(trunk_fwd, dim3(grid), dim3(512), LDS_BYTES, stream, a); }
#endif
}
```

```cpp
#include <hip/hip_runtime.h>
#include <hip/hip_cooperative_groups.h>
#include <cstdio>
#include <cstdint>
namespace cg = cooperative_groups;
#ifndef MK_N_LAUNCHES
#define MK_N_LAUNCHES 1
#endif
namespace pg8 {
#define PG8_LAS __attribute__((address_space(3)))
typedef unsigned short bf16_t;
typedef short bf16x8 __attribute__((ext_vector_type(8)));
typedef float f32x4 __attribute__((ext_vector_type(4)));
typedef unsigned u32x4 __attribute__((ext_vector_type(4)));
constexpr int BM = 256, BK = 64, HALF = 128, HTB = HALF * BK * 2  , STAGE_BYTES = 8 * HTB, NXCD = 8, WGM = 8;

__host__ __device__ __forceinline__ int lds_byte(int r, int c) { const int st = (r >> 4) * 2 + (c >> 5), rr = r & 15, cc = c & 31, ob = rr * 64 + cc * 2; return st * 1024 + (ob ^ (((ob >> 9) & 1) << 5)); }
__host__ __device__ __forceinline__ void stage_rc(int b, int& R, int& C) { const int st = b / 1024, sb = b % 1024, swz = sb ^ (((sb >> 9) & 1) << 5); R = (st >> 1) * 16 + swz / 64; C = (st & 1) * 32 + (swz % 64) / 2; }
__host__ __device__ __forceinline__ int perm32(int rho) { const int n = rho >> 4, i = rho & 15; return 8 * (i >> 2) + 4 * n + (i & 3); }

struct Unit { int pm, pn; };
struct Gemm { const bf16_t* A; const bf16_t* Bt; int M, N, K; };

struct StaticOrder {
    int nM, nN, nwg, G, c;
    __host__ __device__ void init(int M, int N, int G_, int c_) { nM = M / BM; nN = N / BM; nwg = nM * nN; G = G_; c = c_; }
    __host__ __device__ bool next(int i, Unit& u) const {
        const long L = (long)i * G + c; if (L >= nwg) return false;
        int wgid = (int)L; { const int q = nwg / NXCD, r = nwg % NXCD, xcd = wgid % NXCD, off = wgid / NXCD; wgid = (xcd < r ? xcd * (q + 1) : r * (q + 1) + (xcd - r) * q) + off; }
        const int nig = WGM * nN, gid = wgid / nig, fm = gid * WGM, gsz = (nM - fm) < WGM ? (nM - fm) : WGM;
        u.pm = fm + ((wgid % nig) % gsz); u.pn = (wgid % nig) / gsz; return true;
    }
    __device__ __forceinline__ void a_ready(const Unit&) const {}
    __device__ __forceinline__ void done(const Unit&) const {}
};

__device__ __forceinline__ unsigned cvt_pk_bf16(float lo, float hi) { typedef float f2_ __attribute__((ext_vector_type(2))); typedef __bf16 b2_ __attribute__((ext_vector_type(2))); f2_ v = {lo, hi}; b2_ b = __builtin_convertvector(v, b2_); return __builtin_bit_cast(unsigned, b); }
template <class Epi, class Sched, bool ALIGN_EPI = false, bool SP2 = false>
__device__ __forceinline__ void gemm_phase(PG8_LAS unsigned char* lds, const Gemm g, const Sched& S, const Epi& E) {
    const int tid = threadIdx.x, wid = __builtin_amdgcn_readfirstlane(tid >> 6), lane = tid & 63, wr = wid >> 2, wc = wid & 3, fr = lane & 15, fq = lane >> 4;
    const int K = g.K, nt = K / BK;
    unsigned voffA[2], voffB[2];
#pragma unroll
    for (int i = 0; i < 2; ++i) { int R, C; stage_rc(tid * 16 + i * 8192, R, C); const int Rb = Epi::PERM ? ((R & ~31) + perm32(R & 31)) : R;
        voffA[i] = (unsigned)(R * K + C) * 2u; voffB[i] = (unsigned)(Rb * K + C) * 2u; }
    const size_t kstep = (size_t)(BK * 2);
    const size_t hstep = (size_t)HALF * K * 2;
    const size_t tstep = 2 * hstep;
    const unsigned ldsw = (unsigned)wid * 1024u;
    const int aoff = lds_byte(wr * 64 + fr, fq * 8), boff = lds_byte(wc * 32 + fr, fq * 8);
#define PG8_SA(b, h) (((b) * 2 + (h)) * HTB)
#define PG8_SB(b, h) ((4 + (b) * 2 + (h)) * HTB)
#define PG8_STAGE(bufoff, gbase, voff) do { _Pragma("unroll") for (int _i = 0; _i < 2; ++_i) \
        __builtin_amdgcn_global_load_lds((const unsigned*)((const char*)(gbase) + (voff)[_i]), (PG8_LAS unsigned*)(lds + (bufoff) + ldsw + _i * 8192), 16, 0, 0); } while (0)
#define PG8_LDA(dst, b, h) do { _Pragma("unroll") for (int m = 0; m < 4; ++m) _Pragma("unroll") for (int k = 0; k < 2; ++k) dst[m][k] = *(const PG8_LAS bf16x8*)(lds + PG8_SA(b, h) + aoff + m * 2048 + k * 1024); } while (0)
#define PG8_LDB(dst, b, h) do { _Pragma("unroll") for (int n = 0; n < 2; ++n) _Pragma("unroll") for (int k = 0; k < 2; ++k) dst[n][k] = *(const PG8_LAS bf16x8*)(lds + PG8_SB(b, h) + boff + n * 2048 + k * 1024); } while (0)
#define PG8_MMA(ai, bj, At, Bt) do { __builtin_amdgcn_s_setprio(1); _Pragma("unroll") for (int m = 0; m < 4; ++m) _Pragma("unroll") for (int n = 0; n < 2; ++n) _Pragma("unroll") for (int k = 0; k < 2; ++k) \
        acc[ai][bj][m][n] = __builtin_amdgcn_mfma_f32_16x16x32_bf16(Bt[n][k], At[m][k], acc[ai][bj][m][n], 0, 0, 0); __builtin_amdgcn_s_setprio(0); } while (0)
#define PG8_WAIT_V(n) asm volatile("s_waitcnt vmcnt(" #n ")" ::: "memory")
#define PG8_WAIT_L(n) asm volatile("s_waitcnt lgkmcnt(" #n ")" ::: "memory")
#define PG8_BAR __builtin_amdgcn_s_barrier()
#define PG8_SCHED __builtin_amdgcn_sched_barrier(0)
    Unit cur, nxt; int ui = 0;
    if (!S.next(0, cur)) return;
    f32x4 acc[2][2][4][2];
#pragma unroll
    for (int a = 0; a < 2; ++a)
#pragma unroll
        for (int b = 0; b < 2; ++b)
#pragma unroll
            for (int m = 0; m < 4; ++m)
#pragma unroll
                for (int n = 0; n < 2; ++n) acc[a][b][m][n] = (f32x4){0.f, 0.f, 0.f, 0.f};
    bf16x8 At[4][2], B0[2][2], B1[2][2];
    const char* cA = (const char*)g.A + (size_t)cur.pm * tstep; const char* cB = (const char*)g.Bt + (size_t)cur.pn * tstep;
    S.a_ready(cur);
    if constexpr (SP2) {
        PG8_STAGE(PG8_SB(0, 0), cB, voffB); PG8_STAGE(PG8_SB(0, 1), cB + hstep, voffB); PG8_STAGE(PG8_SA(0, 0), cA, voffA); PG8_STAGE(PG8_SA(0, 1), cA + hstep, voffA);
        if (wr == 1) PG8_BAR;
        PG8_WAIT_V(2); PG8_BAR;
        PG8_STAGE(PG8_SB(1, 0), cB + kstep, voffB); PG8_STAGE(PG8_SA(1, 0), cA + kstep, voffA); PG8_STAGE(PG8_SB(1, 1), cB + hstep + kstep, voffB);
        PG8_WAIT_V(6); PG8_BAR;
    } else {
        PG8_STAGE(PG8_SB(0, 0), cB, voffB); PG8_STAGE(PG8_SA(0, 0), cA, voffA); PG8_STAGE(PG8_SB(0, 1), cB + hstep, voffB); PG8_STAGE(PG8_SA(0, 1), cA + hstep, voffA);
        if (wr == 1) PG8_BAR;
        PG8_WAIT_V(4); PG8_BAR;
        PG8_STAGE(PG8_SB(1, 0), cB + kstep, voffB); PG8_STAGE(PG8_SA(1, 0), cA + kstep, voffA); PG8_STAGE(PG8_SB(1, 1), cB + hstep + kstep, voffB);
        PG8_WAIT_V(6); PG8_BAR;
    }
    for (;;) {
        const bool has_next = S.next(ui + 1, nxt);
        const char* nA = has_next ? (const char*)g.A + (size_t)nxt.pm * tstep : cA; const char* nB = has_next ? (const char*)g.Bt + (size_t)nxt.pn * tstep : cB;
        for (int t = 0; t < nt; t += 2) {
            const bool last = (t == nt - 2);
            const char* a1 = cA + (size_t)(t + 1) * kstep;
            const char* a2 = last ? nA : cA + (size_t)(t + 2) * kstep; const char* b2 = last ? nB : cB + (size_t)(t + 2) * kstep;
            const char* a3 = a2 + kstep; const char* b3 = b2 + kstep;
            if (last && has_next) S.a_ready(nxt);
            if constexpr (SP2) {
            PG8_LDB(B0, 0, 0); PG8_LDB(B1, 0, 1); PG8_SCHED; PG8_LDA(At, 0, 0); PG8_STAGE(PG8_SA(1, 1), a1 + hstep, voffA);
            PG8_WAIT_V(8); PG8_WAIT_L(0); PG8_BAR; PG8_MMA(0, 0, At, B0); PG8_MMA(0, 1, At, B1); PG8_BAR; PG8_SCHED;
            PG8_LDA(At, 0, 1); PG8_STAGE(PG8_SB(0, 0), b2, voffB); PG8_STAGE(PG8_SB(0, 1), b2 + hstep, voffB); PG8_STAGE(PG8_SA(0, 0), a2, voffA);
            PG8_WAIT_V(8); PG8_WAIT_L(0); PG8_BAR; PG8_MMA(1, 0, At, B0); PG8_MMA(1, 1, At, B1); PG8_BAR; PG8_SCHED;
            PG8_LDB(B0, 1, 0); PG8_LDB(B1, 1, 1); PG8_SCHED; PG8_LDA(At, 1, 0); PG8_STAGE(PG8_SA(0, 1), a2 + hstep, voffA);
            PG8_WAIT_V(8); PG8_WAIT_L(0); PG8_BAR; PG8_MMA(0, 0, At, B0); PG8_MMA(0, 1, At, B1); PG8_BAR; PG8_SCHED;
            PG8_LDA(At, 1, 1); PG8_STAGE(PG8_SB(1, 0), b3, voffB); PG8_STAGE(PG8_SB(1, 1), b3 + hstep, voffB); PG8_STAGE(PG8_SA(1, 0), a3, voffA);
            PG8_WAIT_V(8); PG8_WAIT_L(0); PG8_BAR; PG8_MMA(1, 0, At, B0); PG8_MMA(1, 1, At, B1); PG8_BAR; PG8_SCHED;
            } else {
            PG8_LDB(B0, 0, 0); PG8_SCHED; PG8_LDA(At, 0, 0); PG8_STAGE(PG8_SA(1, 1), a1 + hstep, voffA);
            PG8_WAIT_L(8); PG8_BAR; PG8_WAIT_L(0); PG8_MMA(0, 0, At, B0); PG8_BAR; PG8_SCHED;
            PG8_LDB(B1, 0, 1); PG8_STAGE(PG8_SB(0, 0), b2, voffB);
            PG8_BAR; PG8_WAIT_L(0); PG8_MMA(0, 1, At, B1); PG8_BAR;
            PG8_LDA(At, 0, 1); PG8_STAGE(PG8_SA(0, 0), a2, voffA);
            PG8_BAR; PG8_WAIT_L(0); PG8_MMA(1, 0, At, B0); PG8_BAR; PG8_SCHED;
            PG8_STAGE(PG8_SB(0, 1), b2 + hstep, voffB);
            PG8_WAIT_V(6); PG8_BAR; PG8_MMA(1, 1, At, B1); PG8_BAR;
            PG8_LDB(B0, 1, 0); PG8_SCHED; PG8_LDA(At, 1, 0); PG8_STAGE(PG8_SA(0, 1), a2 + hstep, voffA);
            PG8_WAIT_L(8); PG8_BAR; PG8_WAIT_L(0); PG8_MMA(0, 0, At, B0); PG8_BAR; PG8_SCHED;
            PG8_LDB(B1, 1, 1); PG8_STAGE(PG8_SB(1, 0), b3, voffB);
            PG8_BAR; PG8_WAIT_L(0); PG8_MMA(0, 1, At, B1); PG8_BAR;
            PG8_LDA(At, 1, 1); PG8_STAGE(PG8_SA(1, 0), a3, voffA);
            PG8_BAR; PG8_WAIT_L(0); PG8_MMA(1, 0, At, B0); PG8_BAR; PG8_SCHED;
            PG8_STAGE(PG8_SB(1, 1), b3 + hstep, voffB);
            PG8_WAIT_V(6); PG8_BAR; PG8_MMA(1, 1, At, B1); PG8_BAR;
            }
        }
        if constexpr (ALIGN_EPI) { if (wr == 0) PG8_BAR; }
        if constexpr (!Epi::AFTER_DRAIN) { E(acc, cur, wr, wc, fr, fq); S.done(cur); }
        if (!has_next) break;
#pragma unroll
        for (int a = 0; a < 2; ++a)
#pragma unroll
            for (int b = 0; b < 2; ++b)
#pragma unroll
                for (int m = 0; m < 4; ++m)
#pragma unroll
                    for (int n = 0; n < 2; ++n) acc[a][b][m][n] = (f32x4){0.f, 0.f, 0.f, 0.f};
        cur = nxt; cA = nA; cB = nB; ++ui;
        if constexpr (ALIGN_EPI) { if (wr == 1) PG8_BAR; }
    }
    PG8_WAIT_V(0);
    if constexpr (!ALIGN_EPI) { if (wr == 0) PG8_BAR; }
    PG8_BAR;
    if constexpr (Epi::AFTER_DRAIN) { E.fused(acc, cur, wr, wc, fr, fq, lds, wid, lane); S.done(cur); }
#undef PG8_SA
#undef PG8_SB
#undef PG8_STAGE
#undef PG8_LDA
#undef PG8_LDB
#undef PG8_MMA
#undef PG8_WAIT_V
#undef PG8_WAIT_L
#undef PG8_BAR
#undef PG8_SCHED
}
}

#define LAS __attribute__((address_space(3)))
typedef unsigned short bf16_t;
typedef float f32x4 __attribute__((ext_vector_type(4)));
typedef float f32x2 __attribute__((ext_vector_type(2)));
typedef unsigned u32x4 __attribute__((ext_vector_type(4)));
typedef unsigned u32x2 __attribute__((ext_vector_type(2)));
typedef short bf16x8 __attribute__((ext_vector_type(8)));
typedef short s16x4 __attribute__((ext_vector_type(4)));

constexpr int DM = 1024, SEQ = 4096, NB = 4, MP = NB * SEQ;
constexpr int DB = 32, DS = 4, MS = DB * DS;
constexpr int MT = MP + MS;
constexpr int MPAD = 16640;
constexpr int PAST = 16384;
constexpr int NIN_A = 5120, DFF = 2816, NUP = 2 * DFF;
constexpr float EPS = 1e-6f;
constexpr float QSCALE = 0.08838834764831845f * 1.4426950408889634f;
constexpr float NEGBIG = -1e30f;

constexpr size_t O_YP = 0;
constexpr size_t O_YS = O_YP + (size_t)MP * DM;
constexpr size_t O_PW0 = O_YS + (size_t)MS * DM;
constexpr size_t O_PW1 = O_PW0 + (size_t)NB * 128 * 1024;
constexpr size_t O_PW2 = O_PW1 + (size_t)NB * 512 * 1024;
constexpr size_t O_PMEM = O_PW2 + (size_t)NB * 2048 * 1024;
constexpr size_t O_PS5 = O_PMEM + (size_t)2 * NB * 256 * 1024;
constexpr size_t O_PCONV = O_PS5 + (size_t)NB * 2 * 32 * 64;
constexpr size_t O_SW0 = O_PCONV + (size_t)2 * NB * 2 * NUP;
constexpr size_t O_SW1 = O_SW0 + (size_t)DB * 128 * 1024;
constexpr size_t O_SW2 = O_SW1 + (size_t)DB * 512 * 1024;
constexpr size_t O_SS5 = O_SW2 + (size_t)DB * 2048 * 1024;
constexpr size_t O_SCONV = O_SS5 + (size_t)DB * 2 * 32 * 64;
constexpr size_t O_END = O_SCONV + (size_t)2 * DB * 2 * NUP;
static_assert(O_END == 119054336, "output size");

constexpr size_t al256(size_t x) { return (x + 255) & ~(size_t)255; }
constexpr size_t WS_SUMSQ = 0;
constexpr size_t WS_BAR = 512u << 10;
constexpr size_t WS_WINA = 1u << 20;
constexpr size_t WS_WINB = WS_WINA + (size_t)NIN_A * DM * 2;
constexpr size_t WS_WGLU = WS_WINB + (size_t)DM * DM * 2;
constexpr size_t WS_WMKV = WS_WGLU + (size_t)512 * 512 * 2;
constexpr size_t WS_WOUT = WS_WMKV + (size_t)2 * DM * DM * 2;
constexpr size_t WS_WUP = WS_WOUT + (size_t)2 * DM * DM * 2;
constexpr size_t WS_WDN = WS_WUP + (size_t)2 * NUP * DM * 2;
constexpr size_t WS_HB = WS_WDN + (size_t)2 * DM * DFF * 2;
constexpr size_t WS_MEMN = WS_HB + (size_t)MPAD * DM * 2;
constexpr size_t WS_MKVR = WS_MEMN + (size_t)2 * DM * DM * 2;
constexpr size_t WS_MKV = WS_MKVR + (size_t)2 * DM * DM * 2;
constexpr size_t WS_SMKV = WS_MKV + (size_t)2 * DM * DM * 2;
constexpr size_t WS_PROJ = WS_SMKV + (size_t)2 * DB * 256 * 1024 * 2;
constexpr size_t WS_PROJ1 = WS_PROJ + (size_t)MPAD * NUP * 2;
constexpr size_t WS_OG = WS_PROJ1 + (size_t)MPAD * DM * 2;
constexpr size_t WS_L2G = WS_OG + (size_t)3 * MT * 512 * 2;
constexpr size_t WS_MERGED = al256(WS_L2G + (size_t)3 * MT * 4 * 4);
constexpr size_t WS_X = WS_MERGED + (size_t)MPAD * DM * 2;
constexpr size_t WS_ACT = WS_X + (size_t)MPAD * DM * 4;
constexpr size_t WS_Y = WS_ACT + (size_t)MPAD * DFF * 2;
constexpr size_t WS_E = WS_Y + (size_t)MPAD * 512 * 2;
constexpr size_t WS_SOG = WS_E + (size_t)NB * 64 * 32 * 64 * 8;
constexpr size_t WS_SL2 = WS_SOG + (size_t)12 * MS * 512 * 4;
constexpr size_t WS_BND = al256(WS_SL2 + (size_t)12 * MS * 4 * 4);
constexpr size_t WS_UPS = WS_BND + (size_t)258 * 4 * NUP * 2;
constexpr size_t WS_END = WS_UPS + (size_t)MS * NUP * 2;
static_assert(WS_END < (size_t)1000 * 1024 * 1024, "ws map");

constexpr int LDS_BYTES = 147456;

struct Args { const float* in[34]; float* out; unsigned char* ws; int ph_lo, ph_hi; };

__device__ __forceinline__ unsigned pk2(float lo, float hi) { return pg8::cvt_pk_bf16(lo, hi); }
__device__ __forceinline__ float bflo(unsigned w) { return __uint_as_float(w << 16); }
__device__ __forceinline__ float bfhi(unsigned w) { return __uint_as_float(w & 0xffff0000u); }
__device__ __forceinline__ float bf2f(bf16_t h) { return __uint_as_float(((unsigned)h) << 16); }
__device__ __forceinline__ bf16_t f2bf(float f) { return (bf16_t)(pk2(f, 0.f) & 0xffffu); }
__device__ __forceinline__ float wave_sum(float v) {
#pragma unroll
    for (int o = 1; o < 64; o <<= 1) v += __shfl_xor(v, o);
    return v;
}
__device__ __forceinline__ float wave_max(float v) {
#pragma unroll
    for (int o = 1; o < 64; o <<= 1) v = fmaxf(v, __shfl_xor(v, o));
    return v;
}
#define LDS_WAIT() asm volatile("s_waitcnt lgkmcnt(0)" ::: "memory")
__device__ __forceinline__ void unpack8(const u32x4 w, float (&x)[8]) { x[0] = bflo(w.x); x[1] = bfhi(w.x); x[2] = bflo(w.y); x[3] = bfhi(w.y); x[4] = bflo(w.z); x[5] = bfhi(w.z); x[6] = bflo(w.w); x[7] = bfhi(w.w); }
__device__ __forceinline__ void load8f(const float* p, float (&x)[8]) { const f32x4 a = *(const f32x4*)p, b = *(const f32x4*)(p + 4); x[0] = a[0]; x[1] = a[1]; x[2] = a[2]; x[3] = a[3]; x[4] = b[0]; x[5] = b[1]; x[6] = b[2]; x[7] = b[3]; }

struct EpiStoreBf16 {
    static constexpr bool PERM = true, AFTER_DRAIN = false;
    bf16_t* O; int ldc; const float* sumsq;
    __device__ __forceinline__ void operator()(const f32x4 (&acc)[2][2][4][2], const pg8::Unit& u, int wr, int wc, int fr, int fq) const {
        const int row0 = u.pm * 256 + wr * 64 + fr, col0 = u.pn * 256 + wc * 32 + 8 * fq;
#pragma unroll
        for (int ai = 0; ai < 2; ++ai)
#pragma unroll
            for (int m = 0; m < 4; ++m) {
                const int row = row0 + ai * 128 + m * 16;
                float sc = 1.f; if (sumsq) sc = rsqrtf(sumsq[row] * (1.f / 1024.f) + EPS);
                bf16_t* rowp = O + (size_t)row * ldc + col0;
#pragma unroll
                for (int bj = 0; bj < 2; ++bj) { const f32x4 v0 = acc[ai][bj][m][0] * sc, v1 = acc[ai][bj][m][1] * sc;
                    u32x4 w; w.x = pk2(v0[0], v0[1]); w.y = pk2(v0[2], v0[3]); w.z = pk2(v1[0], v1[1]); w.w = pk2(v1[2], v1[3]);
                    *(u32x4*)(rowp + bj * 128) = w; }
            }
    }
};
struct EpiGlu {
    static constexpr bool PERM = true, AFTER_DRAIN = false;
    bf16_t* O; int ldc; const bf16_t* Y; const float* bias;
    __device__ __forceinline__ void operator()(const f32x4 (&acc)[2][2][4][2], const pg8::Unit& u, int wr, int wc, int fr, int fq) const {
        const int row0 = u.pm * 256 + wr * 64 + fr, col0 = u.pn * 256 + wc * 32 + 8 * fq;
#pragma unroll
        for (int bj = 0; bj < 2; ++bj) {
            const f32x4 b0 = *(const f32x4*)(bias + col0 + bj * 128), b1 = *(const f32x4*)(bias + col0 + bj * 128 + 4);
#pragma unroll
            for (int ai = 0; ai < 2; ++ai)
#pragma unroll
                for (int m = 0; m < 4; ++m) {
                    const int row = row0 + ai * 128 + m * 16;
                    const u32x4 yw = *(const u32x4*)(Y + (size_t)row * 512 + col0 + bj * 128);
                    const f32x4 z0 = acc[ai][bj][m][0] + b0, z1 = acc[ai][bj][m][1] + b1;
                    float y[8] = {bflo(yw.x), bfhi(yw.x), bflo(yw.y), bfhi(yw.y), bflo(yw.z), bfhi(yw.z), bflo(yw.w), bfhi(yw.w)};
                    float o[8];
#pragma unroll
                    for (int e = 0; e < 4; ++e) { o[e] = y[e] * __builtin_amdgcn_rcpf(1.f + __expf(-z0[e])); o[4 + e] = y[4 + e] * __builtin_amdgcn_rcpf(1.f + __expf(-z1[e])); }
                    u32x4 w; w.x = pk2(o[0], o[1]); w.y = pk2(o[2], o[3]); w.z = pk2(o[4], o[5]); w.w = pk2(o[6], o[7]);
                    *(u32x4*)(O + (size_t)row * ldc + col0 + bj * 128) = w;
                }
        }
    }
};
struct EpiResidual {
    static constexpr bool PERM = false, AFTER_DRAIN = false;
    const float* base_p; const float* base_s; float* out_p; float* out_s; float* sumsq; bf16_t* hb; const float* g;
    __device__ __forceinline__ void operator()(const f32x4 (&acc)[2][2][4][2], const pg8::Unit& u, int wr, int wc, int fr, int fq) const {
        const int col0 = u.pn * 256 + wc * 32 + 4 * fq;
#pragma unroll
        for (int ai = 0; ai < 2; ++ai)
#pragma unroll
            for (int m = 0; m < 4; ++m) {
                const int row = u.pm * 256 + ai * 128 + wr * 64 + m * 16 + fr;
                float ss = 0.f;
                if (row < MT) {
                    const float* b = row < MP ? base_p + (size_t)row * DM : base_s + (size_t)(row - MP) * DM;
                    float* o = row < MP ? out_p + (size_t)row * DM : out_s + (size_t)(row - MP) * DM;
#pragma unroll
                    for (int bj = 0; bj < 2; ++bj)
#pragma unroll
                        for (int n = 0; n < 2; ++n) { const int c = col0 + bj * 128 + n * 16;
                            const f32x4 v = acc[ai][bj][m][n] + *(const f32x4*)(b + c);
                            *(f32x4*)(o + c) = v; ss += (v[0] * v[0] + v[1] * v[1]) + (v[2] * v[2] + v[3] * v[3]);
                            if (hb) { const f32x4 gv = *(const f32x4*)(g + c); u32x2 w; w.x = pk2(v[0] * gv[0], v[1] * gv[1]); w.y = pk2(v[2] * gv[2], v[3] * gv[3]);
                                *(u32x2*)(hb + (size_t)row * DM + c) = w; } }
                }
                ss += __shfl_xor(ss, 16); ss += __shfl_xor(ss, 32);
                if (sumsq && fq == 0 && row < MT) atomicAdd(sumsq + row, ss);
            }
    }
};


__device__ __forceinline__ float dpp_f(float oldv, float src, const int ctrl_sel) {
    const int o = __float_as_int(oldv), s = __float_as_int(src);
    int r;
    if (ctrl_sel == 0) r = __builtin_amdgcn_update_dpp(o, s, 0x121, 0xf, 0xf, false);
    else if (ctrl_sel == 1) r = __builtin_amdgcn_update_dpp(o, s, 0x122, 0xf, 0xf, false);
    else if (ctrl_sel == 2) r = __builtin_amdgcn_update_dpp(o, s, 0x111, 0xf, 0xf, false);
    else r = __builtin_amdgcn_update_dpp(o, s, 0x112, 0xf, 0xf, false);
    return __int_as_float(r);
}
struct EpiUpConv {
    static constexpr bool PERM = true, AFTER_DRAIN = false;
    bf16_t* ACT; const float* sumsq; const float* cw; const float* cb; bf16_t* BND; bf16_t* UPS;
    __device__ __forceinline__ void operator()(const f32x4 (&acc)[2][2][4][2], const pg8::Unit& u, int wr, int wc, int fr, int fq) const {
        const int chan0 = u.pn * 128 + wc * 32 + 8 * fq;
        if (u.pm == MP / 256) {
#pragma unroll
            for (int ai = 0; ai < 2; ++ai)
#pragma unroll
                for (int m = 0; m < 4; ++m) { const int row = u.pm * 256 + ai * 128 + wr * 64 + m * 16 + fr;
                    if (row < MT) { const float sc = rsqrtf(sumsq[row] * (1.f / 1024.f) + EPS);
#pragma unroll
                        for (int bj = 0; bj < 2; ++bj) { const f32x4 v0 = acc[ai][bj][m][0] * sc, v1 = acc[ai][bj][m][1] * sc;
                            u32x4 w; w.x = pk2(v0[0], v0[1]); w.y = pk2(v0[2], v0[3]); w.z = pk2(v1[0], v1[1]); w.w = pk2(v1[2], v1[3]);
                            *(u32x4*)(UPS + ((size_t)(row - MP) * 2 + bj) * DFF + chan0) = w; } } }
            return;
        }
#pragma unroll
        for (int n2 = 0; n2 < 2; ++n2) {
            const int ch = chan0 + 4 * n2;
            f32x4 wa[3], wb[3];
#pragma unroll
            for (int j = 0; j < 3; ++j) { wa[j] = *(const f32x4*)(cw + j * NUP + ch); wb[j] = *(const f32x4*)(cw + j * NUP + DFF + ch); }
            const f32x4 ba = *(const f32x4*)(cb + ch), bb = *(const f32x4*)(cb + DFF + ch);
#pragma unroll
            for (int ai = 0; ai < 2; ++ai) {
                f32x4 pa = {0.f, 0.f, 0.f, 0.f}, pb = {0.f, 0.f, 0.f, 0.f};
#pragma unroll
                for (int m = 0; m < 4; ++m) {
                    const int row = u.pm * 256 + ai * 128 + wr * 64 + m * 16 + fr;
                    const float sc = rsqrtf(sumsq[row] * (1.f / 1024.f) + EPS);
                    const f32x4 ca = acc[ai][0][m][n2] * sc, cbv = acc[ai][1][m][n2] * sc;
                    if ((m == 0 && fr < 2) || (m == 3 && fr >= 14)) { const int slab = row >> 6, k = (m == 0) ? fr : fr - 12;
                        u32x2 w; w.x = pk2(ca[0], ca[1]); w.y = pk2(ca[2], ca[3]); *(u32x2*)(BND + ((size_t)(slab * 4 + k) * 2 + 0) * DFF + ch) = w;
                        w.x = pk2(cbv[0], cbv[1]); w.y = pk2(cbv[2], cbv[3]); *(u32x2*)(BND + ((size_t)(slab * 4 + k) * 2 + 1) * DFF + ch) = w; }
                    f32x4 o;
#pragma unroll
                    for (int e = 0; e < 4; ++e) {
                        const float a1 = dpp_f(dpp_f(0.f, pa[e], 0), ca[e], 2), a2 = dpp_f(dpp_f(0.f, pa[e], 1), ca[e], 3);
                        const float b1 = dpp_f(dpp_f(0.f, pb[e], 0), cbv[e], 2), b2 = dpp_f(dpp_f(0.f, pb[e], 1), cbv[e], 3);
                        const float A = ba[e] + wa[0][e] * a2 + wa[1][e] * a1 + wa[2][e] * ca[e];
                        const float B = bb[e] + wb[0][e] * b2 + wb[1][e] * b1 + wb[2][e] * cbv[e];
                        o[e] = A / (1.f + __expf(-A)) * B; }
                    u32x2 w; w.x = pk2(o[0], o[1]); w.y = pk2(o[2], o[3]);
                    *(u32x2*)(ACT + (size_t)row * DFF + ch) = w;
                    pa = ca; pb = cbv;
                }
            }
        }
    }
};

template <class F> __device__ __forceinline__ void skinny_gemm(const bf16_t* A, const bf16_t* Bt, int K, int N, const F& f) {
    const int lane = threadIdx.x & 63, wave = threadIdx.x >> 6, l16 = lane & 15, quad = lane >> 4;
    const int gwr = ((int)gridDim.x - 1 - (int)blockIdx.x) * 8 + wave, NGW = gridDim.x * 8;
    const int ntile = 8 * (N >> 4);
    for (int wi = gwr; wi < ntile; wi += NGW) {
        const int rt = wi & 7, ct = wi >> 3;
        const bf16_t* ap = A + (size_t)(MP + rt * 16 + l16) * K + quad * 8;
        const bf16_t* bp = Bt + (size_t)(ct * 16 + l16) * K + quad * 8;
        f32x4 acc0 = {0.f, 0.f, 0.f, 0.f}, acc1 = {0.f, 0.f, 0.f, 0.f};
        int k = 0;
        for (; k + 512 <= K; k += 512) {
            bf16x8 af[16], bf[16];
#pragma unroll
            for (int u = 0; u < 16; ++u) { af[u] = *(const bf16x8*)(ap + k + u * 32); bf[u] = *(const bf16x8*)(bp + k + u * 32); }
#pragma unroll
            for (int u = 0; u < 16; u += 2) { acc0 = __builtin_amdgcn_mfma_f32_16x16x32_bf16(af[u], bf[u], acc0, 0, 0, 0); acc1 = __builtin_amdgcn_mfma_f32_16x16x32_bf16(af[u + 1], bf[u + 1], acc1, 0, 0, 0); }
        }
        for (; k < K; k += 256) {
            bf16x8 af[8], bf[8];
#pragma unroll
            for (int u = 0; u < 8; ++u) { af[u] = *(const bf16x8*)(ap + k + u * 32); bf[u] = *(const bf16x8*)(bp + k + u * 32); }
#pragma unroll
            for (int u = 0; u < 8; u += 2) { acc0 = __builtin_amdgcn_mfma_f32_16x16x32_bf16(af[u], bf[u], acc0, 0, 0, 0); acc1 = __builtin_amdgcn_mfma_f32_16x16x32_bf16(af[u + 1], bf[u + 1], acc1, 0, 0, 0); }
        }
        const f32x4 acc = acc0 + acc1;
#pragma unroll
        for (int j = 0; j < 4; ++j) f(MP + rt * 16 + quad * 4 + j, ct * 16 + l16, acc[j]);
    }
}

template <class F> __device__ __forceinline__ void skinny_gemm_splitk(const bf16_t* A, const bf16_t* Bt, int K, int N, const F& f, LAS unsigned char* lds) {
    const int lane = threadIdx.x & 63, wave = threadIdx.x >> 6, l16 = lane & 15, quad = lane >> 4;
    const int nunit = 8 * (N >> 4), nks = K >> 8;
    LAS f32x4* part = (LAS f32x4*)lds;
    for (int un = (int)gridDim.x - 1 - (int)blockIdx.x; un < nunit; un += gridDim.x) {
        const int rt = un & 7, ct = un >> 3;
        const bf16_t* ap = A + (size_t)(MP + rt * 16 + l16) * K + wave * (K >> 3) + quad * 8;
        const bf16_t* bp = Bt + (size_t)(ct * 16 + l16) * K + wave * (K >> 3) + quad * 8;
        bf16x8 af[11], bf[11];
#pragma unroll
        for (int u = 0; u < 11; ++u) if (u < nks) { af[u] = *(const bf16x8*)(ap + u * 32); bf[u] = *(const bf16x8*)(bp + u * 32); }
        f32x4 acc = {0.f, 0.f, 0.f, 0.f};
#pragma unroll
        for (int u = 0; u < 11; ++u) if (u < nks) acc = __builtin_amdgcn_mfma_f32_16x16x32_bf16(af[u], bf[u], acc, 0, 0, 0);
        asm volatile("s_nop 15\n\ts_nop 15" : "+v"(acc));
        part[wave * 64 + lane] = acc;
        __syncthreads();
        if (wave == 0) {
            f32x4 s = part[lane];
#pragma unroll
            for (int w = 1; w < 8; ++w) s += part[w * 64 + lane];
#pragma unroll
            for (int j = 0; j < 4; ++j) f(MP + rt * 16 + quad * 4 + j, ct * 16 + l16, s[j]);
        }
        __syncthreads();
    }
}
struct SkStore { bf16_t* O; int ldc; const float* sumsq;
    __device__ __forceinline__ void operator()(int row, int col, float v) const { float sc = 1.f; if (sumsq) sc = rsqrtf(sumsq[row] * (1.f / 1024.f) + EPS); O[(size_t)row * ldc + col] = f2bf(v * sc); } };
struct SkGlu { bf16_t* O; int ldc; const bf16_t* Y; const float* bias;
    __device__ __forceinline__ void operator()(int row, int col, float v) const { const float y = bf2f(Y[(size_t)row * 512 + col]); O[(size_t)row * ldc + col] = f2bf(y / (1.f + __expf(-(v + bias[col])))); } };
struct SkResidual { const float* base_s; float* out_s; float* sumsq; bf16_t* hb; const float* g;
    __device__ __forceinline__ void operator()(int row, int col, float v) const {
        const float xn = base_s[(size_t)(row - MP) * DM + col] + v; out_s[(size_t)(row - MP) * DM + col] = xn;
        float ss = xn * xn; ss += __shfl_xor(ss, 1); ss += __shfl_xor(ss, 2); ss += __shfl_xor(ss, 4); ss += __shfl_xor(ss, 8);
        if (sumsq && (threadIdx.x & 15) == 0) atomicAdd(sumsq + row, ss);
        if (hb) hb[(size_t)row * DM + col] = f2bf(xn * g[col]); } };

__device__ __forceinline__ void transpose_item(const float* W, int K, int N, bf16_t* WT, LAS float* scr, int item, int lane, const bool up_perm = false) {
    const int nblk = N / 32, kb = item / nblk, nb = item % nblk, k0 = 64 * kb, n0 = 32 * nb;
    float tv[32];
#pragma unroll
    for (int i = 0; i < 32; ++i) { const int kk = 2 * i + (lane >> 5); tv[i] = W[(size_t)(k0 + kk) * N + n0 + (lane & 31)]; }
#pragma unroll
    for (int i = 0; i < 32; ++i) { const int kk = 2 * i + (lane >> 5); scr[kk * 33 + (lane & 31)] = tv[i]; }
    LDS_WAIT();
    const int c = lane & 7;
#pragma unroll
    for (int j = 0; j < 4; ++j) { const int n = (lane >> 3) + 8 * j; const LAS float* s = scr + (8 * c) * 33 + n;
        u32x4 o; o.x = pk2(s[0 * 33], s[1 * 33]); o.y = pk2(s[2 * 33], s[3 * 33]); o.z = pk2(s[4 * 33], s[5 * 33]); o.w = pk2(s[6 * 33], s[7 * 33]);
        int nr = n0 + n; if (up_perm) { const int half = nr >= DFF ? 1 : 0, chn = nr - half * DFF; nr = (chn >> 7) * 256 + half * 128 + (chn & 127); }
        *(u32x4*)(WT + (size_t)nr * K + k0 + 8 * c) = o; }
    LDS_WAIT();
}
__device__ __forceinline__ void rms_row_to_bf16(const float* xrow, const float* g, bf16_t* orow, int lane) {
    const f32x4* xr = (const f32x4*)xrow + lane; const f32x4* gr = (const f32x4*)g + lane;
    f32x4 v[4]; float s = 0.f;
#pragma unroll
    for (int j = 0; j < 4; ++j) { v[j] = xr[64 * j]; s += (v[j].x * v[j].x + v[j].y * v[j].y) + (v[j].z * v[j].z + v[j].w * v[j].w); }
    const float r = rsqrtf(wave_sum(s) * (1.f / 1024.f) + EPS);
    u32x2* o8 = (u32x2*)orow + lane;
#pragma unroll
    for (int j = 0; j < 4; ++j) { const f32x4 gv = gr[64 * j]; u32x2 w; w.x = pk2(v[j].x * r * gv.x, v[j].y * r * gv.y); w.y = pk2(v[j].z * r * gv.z, v[j].w * r * gv.w); o8[64 * j] = w; }
}

template <int L> __device__ __forceinline__ void win_copy(const float* src, float* dst, size_t lo, size_t hi, size_t tw, size_t stride) {
    constexpr size_t per = (size_t)(L - DS) * 256;
    const f32x4* s4 = (const f32x4*)src; f32x4* d4 = (f32x4*)dst;
    for (size_t i0 = lo + tw; i0 < hi; i0 += stride * 16) {
        f32x4 v[16]; size_t di[16];
#pragma unroll
        for (int u = 0; u < 16; ++u) { const size_t i = i0 + u * stride; const bool ok = i < hi; const size_t ii = ok ? i : lo; const size_t b = ii / per, rem = ii - b * per;
            di[u] = ok ? b * (size_t)L * 256 + rem : ~(size_t)0; v[u] = __builtin_nontemporal_load(s4 + b * (size_t)L * 256 + 1024 + rem); }
#pragma unroll
        for (int u = 0; u < 16; ++u) if (di[u] != ~(size_t)0) __builtin_nontemporal_store(v[u], d4 + di[u]);
    }
}
constexpr size_t W2_N = (size_t)(2048 - DS) * 256 * DB;
constexpr size_t W2_A = 0, W2_B = 0, W2_C = 0;


constexpr int WCH = 4096;
constexpr unsigned WN2 = (2048 - DS) * 256 * DB, WN1 = (512 - DS) * 256 * DB, WN0 = (128 - DS) * 256 * DB;
constexpr int WC2 = (WN2 + WCH - 1) / WCH, WC1 = (WN1 + WCH - 1) / WCH, WC0 = (WN0 + WCH - 1) / WCH, WCT = WC2 + WC1 + WC0;
__device__ __forceinline__ void win_chunk(const Args& a, int c) {
    int g, cl; if (c < WC2) { g = 2; cl = c; } else if (c < WC2 + WC1) { g = 1; cl = c - WC2; } else { g = 0; cl = c - WC2 - WC1; }
    const unsigned L = 128u << (2 * g), per = (L - DS) * 256u, n = per * DB;
    const f32x4* s4 = (const f32x4*)(g == 2 ? a.in[4] : g == 1 ? a.in[3] : a.in[2]);
    f32x4* d4 = (f32x4*)(a.out + (g == 2 ? O_SW2 : g == 1 ? O_SW1 : O_SW0));
    f32x4 v[8]; unsigned di[8];
#pragma unroll
    for (int u = 0; u < 8; ++u) { const unsigned i = (unsigned)cl * WCH + u * 512 + threadIdx.x; const bool ok = i < n; const unsigned ii = ok ? i : 0u; const unsigned b = ii / per, rem = ii - b * per;
        di[u] = ok ? b * (L * 256u) + rem : 0xffffffffu; v[u] = __builtin_nontemporal_load(s4 + (size_t)(b * (L * 256u) + 1024u + rem)); }
#pragma unroll
    for (int u = 0; u < 8; ++u) if (di[u] != 0xffffffffu) __builtin_nontemporal_store(v[u], d4 + (size_t)di[u]);
}
__device__ __forceinline__ void win_share(const Args& a, int lo, int hi) { for (int cc = lo + (int)blockIdx.x; cc < hi; cc += gridDim.x) win_chunk(a, cc); }
constexpr int WCA = 1100, WCB = 2100, WCC = 3052;
constexpr int WCD = WCC + 1100, WCE = WCD + 600;
__device__ __forceinline__ void win_idle(const Args& a, int lo, int hi, int first) { const int nb = (int)gridDim.x - first; if ((int)blockIdx.x < first || nb <= 0) return; for (int cc = lo + (int)blockIdx.x - first; cc < hi; cc += nb) win_chunk(a, cc); }

__device__ __forceinline__ void phase_prep(const Args& a, LAS unsigned char* lds) {
    const int tid = threadIdx.x, lane = tid & 63, wave = tid >> 6;
    const int gw = blockIdx.x * 8 + wave, NGW = gridDim.x * 8;
    const size_t gtid = (size_t)blockIdx.x * 512 + tid, nth = (size_t)gridDim.x * 512;
    unsigned char* ws = a.ws;
    { float* sq = (float*)(ws + WS_SUMSQ); for (size_t i = gtid; i < 3 * MPAD; i += nth) sq[i] = 0.f; }
    LAS float* scr = (LAS float*)(lds + wave * 16384);
    constexpr int I_INA = 16 * 160, I_SQ = 16 * 32, I_GLU = 8 * 16, I_UP = 16 * 176, I_DN = 44 * 32;
    constexpr int NITEMS = I_INA + I_SQ + I_GLU + 4 * I_SQ + 2 * I_UP + 2 * I_DN;
    for (int it = gw; it < NITEMS; it += NGW) {
        int r = it;
        if (r < I_INA) { transpose_item(a.in[11], 1024, NIN_A, (bf16_t*)(ws + WS_WINA), scr, r, lane); continue; } r -= I_INA;
        if (r < I_SQ) { transpose_item(a.in[14], 1024, 1024, (bf16_t*)(ws + WS_WINB), scr, r, lane); continue; } r -= I_SQ;
        if (r < I_GLU) { transpose_item(a.in[23], 512, 512, (bf16_t*)(ws + WS_WGLU), scr, r, lane); continue; } r -= I_GLU;
        if (r < 2 * I_SQ) { const int i = r / I_SQ; transpose_item(a.in[26] + (size_t)i * DM * DM, 1024, 1024, (bf16_t*)(ws + WS_WMKV) + (size_t)i * DM * DM, scr, r - i * I_SQ, lane); continue; } r -= 2 * I_SQ;
        if (r < 2 * I_SQ) { const int i = r / I_SQ; transpose_item(a.in[29] + (size_t)i * DM * DM, 1024, 1024, (bf16_t*)(ws + WS_WOUT) + (size_t)i * DM * DM, scr, r - i * I_SQ, lane); continue; } r -= 2 * I_SQ;
        if (r < 2 * I_UP) { const int i = r / I_UP; transpose_item(a.in[30] + (size_t)i * DM * NUP, 1024, NUP, (bf16_t*)(ws + WS_WUP) + (size_t)i * DM * NUP, scr, r - i * I_UP, lane, true); continue; } r -= 2 * I_UP;
        { const int i = r / I_DN; transpose_item(a.in[33] + (size_t)i * DFF * DM, DFF, 1024, (bf16_t*)(ws + WS_WDN) + (size_t)i * DFF * DM, scr, r - i * I_DN, lane); }
    }
    bf16_t* HB = (bf16_t*)(ws + WS_HB);
    for (int m = gw; m < MP; m += 2 * NGW) {
        const int m2 = m + NGW;
        const f32x4* x0 = (const f32x4*)(a.in[0] + (size_t)m * DM) + lane; const f32x4* x1 = (const f32x4*)(a.in[0] + (size_t)(m2 < MP ? m2 : m) * DM) + lane;
        f32x4 v0[4], v1[4]; float s0 = 0.f, s1 = 0.f;
#pragma unroll
        for (int j = 0; j < 4; ++j) { v0[j] = x0[64 * j]; v1[j] = x1[64 * j]; }
#pragma unroll
        for (int j = 0; j < 4; ++j) { s0 += (v0[j].x * v0[j].x + v0[j].y * v0[j].y) + (v0[j].z * v0[j].z + v0[j].w * v0[j].w); s1 += (v1[j].x * v1[j].x + v1[j].y * v1[j].y) + (v1[j].z * v1[j].z + v1[j].w * v1[j].w); }
        const float r0 = rsqrtf(wave_sum(s0) * (1.f / 1024.f) + EPS), r1 = rsqrtf(wave_sum(s1) * (1.f / 1024.f) + EPS);
        const f32x4* gr = (const f32x4*)a.in[9] + lane;
        u32x2* o0 = (u32x2*)(HB + (size_t)m * DM) + lane; u32x2* o1 = (u32x2*)(HB + (size_t)m2 * DM) + lane;
#pragma unroll
        for (int j = 0; j < 4; ++j) { const f32x4 gv = gr[64 * j];
            u32x2 w; w.x = pk2(v0[j].x * r0 * gv.x, v0[j].y * r0 * gv.y); w.y = pk2(v0[j].z * r0 * gv.z, v0[j].w * r0 * gv.w); o0[64 * j] = w;
            if (m2 < MP) { u32x2 w2; w2.x = pk2(v1[j].x * r1 * gv.x, v1[j].y * r1 * gv.y); w2.y = pk2(v1[j].z * r1 * gv.z, v1[j].w * r1 * gv.w); o1[64 * j] = w2; } }
    }
    for (int m = MP + gw; m < MPAD; m += NGW) {
        if (m < MT) rms_row_to_bf16(a.in[1] + (size_t)(m - MP) * DM, a.in[9], HB + (size_t)m * DM, lane);
        else { u32x4 z = {0u, 0u, 0u, 0u}; u32x4* o = (u32x4*)(HB + (size_t)m * DM); o[lane] = z; o[lane + 64] = z; }
    }
    for (int m = gw; m < 2048; m += NGW) { const int i = m >> 10, r = m & 1023;
        rms_row_to_bf16(a.in[8] + (size_t)r * DM, a.in[25] + i * DM, (bf16_t*)(ws + WS_MEMN) + (size_t)m * DM, lane); }
}

__device__ __constant__ double ROPE_INV_TURNS[16] = {0.15915494309189535, 0.07008652158779852, 0.030863763404701233, 0.013591370636193905, 0.005985185712713706, 0.002635675898667413, 0.001160663641240061, 0.0005111175045375439,
    0.00022507907903927658, 9.91173093690194e-05, 4.364795279280288e-05, 1.922110068494486e-05, 8.464330808241401e-06, 3.7274086019153524e-06, 1.641426262795035e-06, 7.228293068832867e-07};

__device__ __forceinline__ void p2_row(const Args& a, int row, int lane) {
    bf16_t* pr = (bf16_t*)(a.ws + WS_PROJ) + (size_t)row * NIN_A;
    const int l16 = lane & 15, hq = lane >> 4;
    const bool samp = row >= MP;
    int b, pos;
    if (!samp) { b = row >> 12; pos = row & 4095; } else { b = (row - MP) >> 2; pos = PAST + ((row - MP) & 3); }
    u32x4 w[9];
#pragma unroll
    for (int i = 0; i < 9; ++i) w[i] = *(const u32x4*)(pr + i * 512 + lane * 8);
    float cs[8], sn[8];
#pragma unroll
    for (int e = 0; e < 8; ++e) { const int j = (8 * l16 + e) & 15; double t = (double)pos * ROPE_INV_TURNS[j]; t -= floor(t); cs[e] = __builtin_amdgcn_cosf((float)t); sn[e] = __builtin_amdgcn_sinf((float)t); }
    const float sgn = (l16 < 2) ? -1.f : 1.f;
    int slot[3]; size_t obase[3];
#pragma unroll
    for (int g = 0; g < 3; ++g) { const int W = 128 << (2 * g);
        obase[g] = g == 0 ? (samp ? O_SW0 : O_PW0) : g == 1 ? (samp ? O_SW1 : O_PW1) : (samp ? O_SW2 : O_PW2);
        slot[g] = samp ? (W - DS + (pos - PAST)) : (pos - (SEQ - W)); }
#pragma unroll
    for (int i = 0; i < 6; ++i) {
        const int which = i / 3, g = i % 3;
        float x[8]; unpack8(w[i], x);
        float ss = 0.f;
#pragma unroll
        for (int e = 0; e < 8; ++e) ss += x[e] * x[e];
        ss += __shfl_xor(ss, 1); ss += __shfl_xor(ss, 2); ss += __shfl_xor(ss, 4); ss += __shfl_xor(ss, 8);
        const float r = rsqrtf(ss * (1.f / 128.f) + EPS);
        float gn[8]; load8f((which == 0 ? a.in[12] : a.in[13]) + g * 128 + 8 * l16, gn);
#pragma unroll
        for (int e = 0; e < 8; ++e) x[e] *= r * gn[e];
        float pt[8];
#pragma unroll
        for (int e = 0; e < 8; ++e) pt[e] = __shfl_xor(x[e], 2);
        if (l16 < 4) {
#pragma unroll
            for (int e = 0; e < 8; ++e) x[e] = x[e] * cs[e] + sgn * pt[e] * sn[e]; }
        if (which == 0) {
            u32x4 o; o.x = pk2(x[0] * QSCALE, x[1] * QSCALE); o.y = pk2(x[2] * QSCALE, x[3] * QSCALE); o.z = pk2(x[4] * QSCALE, x[5] * QSCALE); o.w = pk2(x[6] * QSCALE, x[7] * QSCALE);
            *(u32x4*)(pr + i * 512 + lane * 8) = o;
        } else {
            u32x4 o; o.x = pk2(x[0], x[1]); o.y = pk2(x[2], x[3]); o.z = pk2(x[4], x[5]); o.w = pk2(x[6], x[7]);
            *(u32x4*)(pr + i * 512 + lane * 8) = o;
            const int W = 128 << (2 * g);
            if (slot[g] >= 0) { float* op = a.out + obase[g] + (((size_t)b * W + slot[g]) * 2 + 0) * 512 + hq * 128 + 8 * l16;
                *(f32x4*)op = (f32x4){x[0], x[1], x[2], x[3]}; *(f32x4*)(op + 4) = (f32x4){x[4], x[5], x[6], x[7]}; }
        }
    }
#pragma unroll
    for (int g = 0; g < 3; ++g) {
        const int W = 128 << (2 * g);
        if (slot[g] >= 0) { float x[8]; unpack8(w[6 + g], x);
            float* op = a.out + obase[g] + (((size_t)b * W + slot[g]) * 2 + 1) * 512 + hq * 128 + 8 * l16;
            *(f32x4*)op = (f32x4){x[0], x[1], x[2], x[3]}; *(f32x4*)(op + 4) = (f32x4){x[4], x[5], x[6], x[7]}; }
    }
}
__device__ __forceinline__ void p2_memrow(const Args& a, int m, int lane) {
    const int i = m >> 10, l16 = lane & 15;
    const bf16_t* src = (const bf16_t*)(a.ws + WS_MKVR) + (size_t)m * DM; bf16_t* dst = (bf16_t*)(a.ws + WS_MKV) + (size_t)m * DM;
    float* out = a.out + O_PMEM + (size_t)m * DM;
    const u32x4 wk = *(const u32x4*)(src + lane * 8), wv = *(const u32x4*)(src + 512 + lane * 8);
    float x[8]; unpack8(wk, x);
    float ss = 0.f;
#pragma unroll
    for (int e = 0; e < 8; ++e) ss += x[e] * x[e];
    ss += __shfl_xor(ss, 1); ss += __shfl_xor(ss, 2); ss += __shfl_xor(ss, 4); ss += __shfl_xor(ss, 8);
    const float r = rsqrtf(ss * (1.f / 128.f) + EPS);
    float gn[8]; load8f(a.in[28] + i * 128 + 8 * l16, gn);
#pragma unroll
    for (int e = 0; e < 8; ++e) x[e] *= r * gn[e];
    u32x4 o; o.x = pk2(x[0], x[1]); o.y = pk2(x[2], x[3]); o.z = pk2(x[4], x[5]); o.w = pk2(x[6], x[7]);
    *(u32x4*)(dst + lane * 8) = o; *(u32x4*)(dst + 512 + lane * 8) = wv;
    *(f32x4*)(out + lane * 8) = (f32x4){x[0], x[1], x[2], x[3]}; *(f32x4*)(out + lane * 8 + 4) = (f32x4){x[4], x[5], x[6], x[7]};
    float v[8]; unpack8(wv, v);
    *(f32x4*)(out + 512 + lane * 8) = (f32x4){v[0], v[1], v[2], v[3]}; *(f32x4*)(out + 512 + lane * 8 + 4) = (f32x4){v[4], v[5], v[6], v[7]};
}

struct AttnDesc {
    const bf16_t* Q; long qs;
    const bf16_t* K; const bf16_t* V; long ks;
    int jmin; int band;
    const float* gq;
    const float* Kf; const float* Vf;
    bf16_t* O; long os; float* L2; long ls; int nvalid;
};
__device__ __forceinline__ void attn_load1(const bf16_t* base, const float* basef, long ks, int jmin, u32x4 (&r)[8]) {
    const int tid = threadIdx.x;
    if (basef) {
#pragma unroll
        for (int h = 0; h < 2; ++h) { f32x4 lo[4], hi[4];
#pragma unroll
            for (int i = 0; i < 4; ++i) { const int id = (h * 4 + i) * 512 + tid, key = id >> 4, ch = id & 15; const float* p = basef + (long)key * ks + ch * 8; lo[i] = *(const f32x4*)p; hi[i] = *(const f32x4*)(p + 4); }
#pragma unroll
            for (int i = 0; i < 4; ++i) { u32x4 w; w.x = pk2(lo[i][0], lo[i][1]); w.y = pk2(lo[i][2], lo[i][3]); w.z = pk2(hi[i][0], hi[i][1]); w.w = pk2(hi[i][2], hi[i][3]); r[h * 4 + i] = w; } }
        return;
    }
#pragma unroll
    for (int it = 0; it < 8; ++it) { const int id = it * 512 + tid, key = id >> 4, ch = id & 15;
        if (key >= jmin) r[it] = *(const u32x4*)(base + (long)key * ks + ch * 8); else r[it] = (u32x4){0u, 0u, 0u, 0u}; }
}
__device__ __forceinline__ void attn_stageK(const u32x4 (&kr)[8], LAS unsigned char* lds) {
    const int tid = threadIdx.x;
#pragma unroll
    for (int it = 0; it < 8; ++it) { const int id = it * 512 + tid, key = id >> 4, ch = id & 15;
        *(LAS u32x4*)(lds + key * 256 + ((ch ^ (key & 15)) << 4)) = kr[it]; }
}
__device__ __forceinline__ void attn_stageV(const u32x4 (&vr)[8], LAS unsigned char* lds) {
    const int tid = threadIdx.x;
    LAS unsigned char* Vl = lds + 65536;
#pragma unroll
    for (int it = 0; it < 8; ++it) { const int id = it * 512 + tid, key = id >> 4, ch = id & 15;
        *(LAS u32x4*)(Vl + key * 256 + ((((ch >> 1) ^ (key & 7)) << 5) | ((ch & 1) << 4))) = vr[it]; }
}
__device__ __forceinline__ void attn_qload(const AttnDesc& d, bf16x8 (&qf)[4]) {
    const int lane = threadIdx.x & 63, w = threadIdx.x >> 6, l16 = lane & 15, quad = lane >> 4;
    const bf16_t* qp = d.Q + (long)(16 * w + l16) * d.qs + quad * 8;
    u32x4 qr[4];
#pragma unroll
    for (int ks = 0; ks < 4; ++ks) qr[ks] = *(const u32x4*)(qp + ks * 32);
    if (d.gq) {
        float ss = 0.f;
#pragma unroll
        for (int ks = 0; ks < 4; ++ks) { const float x[8] = {bflo(qr[ks].x), bfhi(qr[ks].x), bflo(qr[ks].y), bfhi(qr[ks].y), bflo(qr[ks].z), bfhi(qr[ks].z), bflo(qr[ks].w), bfhi(qr[ks].w)};
#pragma unroll
            for (int e = 0; e < 8; ++e) ss += x[e] * x[e]; }
        ss += __shfl_xor(ss, 16); ss += __shfl_xor(ss, 32);
        const float r = rsqrtf(ss * (1.f / 128.f) + EPS) * QSCALE;
#pragma unroll
        for (int ks = 0; ks < 4; ++ks) { const f32x4 g0 = *(const f32x4*)(d.gq + ks * 32 + quad * 8), g1 = *(const f32x4*)(d.gq + ks * 32 + quad * 8 + 4);
            qr[ks].x = pk2(bflo(qr[ks].x) * r * g0[0], bfhi(qr[ks].x) * r * g0[1]); qr[ks].y = pk2(bflo(qr[ks].y) * r * g0[2], bfhi(qr[ks].y) * r * g0[3]);
            qr[ks].z = pk2(bflo(qr[ks].z) * r * g1[0], bfhi(qr[ks].z) * r * g1[1]); qr[ks].w = pk2(bflo(qr[ks].w) * r * g1[2], bfhi(qr[ks].w) * r * g1[3]); }
    }
#pragma unroll
    for (int ks = 0; ks < 4; ++ks) qf[ks] = __builtin_bit_cast(bf16x8, qr[ks]);
}
__device__ __forceinline__ void attn_compute(const AttnDesc& d, const bf16x8 (&qf)[4], LAS unsigned char* lds, const bool has, const AttnDesc& dn, u32x4 (&kr)[8], u32x4 (&vr)[8]) {
    const int tid = threadIdx.x, lane = tid & 63, w = tid >> 6, l16 = lane & 15, quad = lane >> 4;
    LAS unsigned char* Kl = lds; LAS unsigned char* Vl = lds + 65536;
    const int band = d.band;
    f32x4 s[16];
#pragma unroll
    for (int n = 0; n < 16; ++n) {
        s[n] = (f32x4){0.f, 0.f, 0.f, 0.f};
        if (!band || (n >= w && n <= w + 8)) {
#pragma unroll
            for (int ks = 0; ks < 4; ++ks) {
                const bf16x8 kf = *(const LAS bf16x8*)(Kl + (16 * n + l16) * 256 + ((((ks << 2) | quad) ^ l16) << 4));
                s[n] = __builtin_amdgcn_mfma_f32_16x16x32_bf16(kf, qf[ks], s[n], 0, 0, 0);
            }
        }
    }
    const int qi = 16 * w + l16;
    float mx = NEGBIG;
#pragma unroll
    for (int n = 0; n < 16; ++n)
#pragma unroll
        for (int j = 0; j < 4; ++j) { const int jj = 16 * n + 4 * quad + j;
            if (band) { const bool ok = (jj >= qi) && (jj <= qi + 128) && (jj >= d.jmin); s[n][j] = ok ? s[n][j] : NEGBIG; }
            mx = fmaxf(mx, s[n][j]); }
    mx = fmaxf(mx, __shfl_xor(mx, 16)); mx = fmaxf(mx, __shfl_xor(mx, 32));
    float lsum = 0.f;
#pragma unroll
    for (int n = 0; n < 16; ++n)
#pragma unroll
        for (int j = 0; j < 4; ++j) { const float p = __builtin_amdgcn_exp2f(s[n][j] - mx); s[n][j] = p; lsum += p; }
    lsum += __shfl_xor(lsum, 16); lsum += __shfl_xor(lsum, 32);
    bf16x8 pf[8];
#pragma unroll
    for (int k2 = 0; k2 < 8; ++k2) { u32x4 t; t.x = pk2(s[2 * k2][0], s[2 * k2][1]); t.y = pk2(s[2 * k2][2], s[2 * k2][3]); t.z = pk2(s[2 * k2 + 1][0], s[2 * k2 + 1][1]); t.w = pk2(s[2 * k2 + 1][2], s[2 * k2 + 1][3]);
        pf[k2] = __builtin_bit_cast(bf16x8, t); }
    attn_stageV(vr, lds);
    __syncthreads();
    if (has) attn_load1(dn.K, dn.Kf, dn.ks, dn.jmin, kr);
    f32x4 o[8];
#pragma unroll
    for (int nd = 0; nd < 8; ++nd) o[nd] = (f32x4){0.f, 0.f, 0.f, 0.f};
    const int kx = ((quad & 1) << 2) | (l16 >> 2);
    const LAS unsigned char* vb = Vl + (4 * quad + (l16 >> 2)) * 256 + 8 * (l16 & 3);
    const int w2 = w >> 1;
#pragma unroll
    for (int k2 = 0; k2 < 8; ++k2) {
        if (!band || (k2 >= w2 && k2 <= w2 + 4)) {
#pragma unroll
            for (int nd = 0; nd < 8; ++nd) {
                const LAS unsigned char* p0 = vb + k2 * 32 * 256 + ((nd ^ kx) << 5);
                const s16x4 lo = __builtin_bit_cast(s16x4, __builtin_amdgcn_ds_read_tr16_b64_v4i16((LAS s16x4*)p0));
                const s16x4 hi = __builtin_bit_cast(s16x4, __builtin_amdgcn_ds_read_tr16_b64_v4i16((LAS s16x4*)(p0 + 16 * 256)));
                const bf16x8 vf = {lo[0], lo[1], lo[2], lo[3], hi[0], hi[1], hi[2], hi[3]};
                o[nd] = __builtin_amdgcn_mfma_f32_16x16x32_bf16(vf, pf[k2], o[nd], 0, 0, 0);
            }
        }
    }
    if (qi < d.nvalid) {
        const float inv = 1.f / lsum;
        bf16_t* op = d.O + (long)qi * d.os + 4 * quad;
#pragma unroll
        for (int nd = 0; nd < 8; ++nd) { u32x2 t; t.x = pk2(o[nd][0] * inv, o[nd][1] * inv); t.y = pk2(o[nd][2] * inv, o[nd][3] * inv); *(u32x2*)(op + 16 * nd) = t; }
        if (d.L2 && quad == 0) d.L2[(long)qi * d.ls] = mx + __builtin_amdgcn_logf(lsum);
    }
}

__device__ __forceinline__ AttnDesc dil_prompt_desc(const Args& a, int it) {
    const int idx32 = it & 31, h = (it >> 5) & 3, g = (it >> 7) % 3, b = it / 384;
    const int rs = 2 * g, r = 1 << rs, nblk = 32 >> rs;
    const int c = idx32 / nblk, blk = idx32 % nblk;
    const bf16_t* P = (const bf16_t*)(a.ws + WS_PROJ);
    AttnDesc d;
    const long row_q0 = (long)b * SEQ + (long)blk * 128 * r + c;
    d.Q = P + row_q0 * NIN_A + g * 512 + h * 128; d.qs = (long)r * NIN_A;
    const long row_k0 = row_q0 - (long)128 * r;
    d.K = P + row_k0 * NIN_A + 1536 + g * 512 + h * 128; d.V = P + row_k0 * NIN_A + 3072 + g * 512 + h * 128; d.ks = (long)r * NIN_A;
    d.jmin = blk == 0 ? 128 : 0; d.band = 1; d.gq = nullptr; d.Kf = nullptr; d.Vf = nullptr;
    d.O = (bf16_t*)(a.ws + WS_OG) + (size_t)g * MT * 512 + row_q0 * 512 + h * 128; d.os = (long)r * 512;
    d.L2 = (float*)(a.ws + WS_L2G) + (size_t)g * MT * 4 + row_q0 * 4 + h; d.ls = (long)r * 4; d.nvalid = 128;
    return d;
}
__device__ __forceinline__ AttnDesc cross_desc(const Args& a, int layer, int it) {
    AttnDesc d; d.jmin = 0; d.band = 0; d.gq = a.in[27] + layer * 128; d.L2 = nullptr; d.ls = 0; d.Kf = nullptr; d.Vf = nullptr;
    const bf16_t* P = layer == 0 ? (const bf16_t*)(a.ws + WS_PROJ) : (const bf16_t*)(a.ws + WS_PROJ1);
    const long pitch = layer == 0 ? NIN_A : DM; const int qcol = layer == 0 ? 4608 : 512;
    bf16_t* MG = (bf16_t*)(a.ws + WS_MERGED);
    d.qs = pitch; d.ks = DM; d.os = DM;
    if (it < 512) { const int h = it & 3, blk = (it >> 2) & 31, b = it >> 7; const long row0 = (long)b * SEQ + blk * 128;
        d.Q = P + row0 * pitch + qcol + h * 128;
        const bf16_t* kv = (const bf16_t*)(a.ws + WS_MKV) + ((size_t)layer * 1024 + b * 256) * DM;
        d.K = kv + h * 128; d.V = kv + 512 + h * 128; d.O = MG + row0 * DM + 512 + h * 128; d.nvalid = 128; }
    else { const int h = it & 3, b = (it - 512) >> 2; const long row0 = MP + b * DS;
        d.Q = P + row0 * pitch + qcol + h * 128;
        const float* kvf = a.in[5] + ((size_t)layer * DB + b) * 256 * DM;
        d.K = nullptr; d.V = nullptr; d.Kf = kvf + h * 128; d.Vf = kvf + 512 + h * 128; d.O = MG + row0 * DM + 512 + h * 128; d.nvalid = DS; }
    return d;
}

__device__ __forceinline__ void sample_dil_item(const Args& a, int wi, int lane) {
    const int kq = wi & 3, h = (wi >> 2) & 3, g = (wi >> 4) % 3, bt = wi / 48, b = bt >> 2, t = bt & 3;
    const int r = 1 << (2 * g), Lb = 128 * r;
    const float* cache = g == 0 ? a.in[2] : g == 1 ? a.in[3] : a.in[4];
    const float* swin = a.out + (g == 0 ? O_SW0 : g == 1 ? O_SW1 : O_SW2);
    const bf16_t* P = (const bf16_t*)(a.ws + WS_PROJ);
    const int rs = b * DS + t; const long row = MP + rs;
    const int hl = lane & 31, par = lane >> 5;
    float q[4]; { const u32x2 w = *(const u32x2*)(P + row * NIN_A + g * 512 + h * 128 + 4 * hl); q[0] = bflo(w.x); q[1] = bfhi(w.x); q[2] = bflo(w.y); q[3] = bfhi(w.y); }
    const size_t boff = (size_t)b * Lb * 1024 + h * 128 + 4 * hl;
    const float* cb = cache + boff; const float* nb = swin + boff - 4 * 1024;
    f32x4 kv[17], vv[17];
#pragma unroll
    for (int u = 0; u < 17; ++u) { const int j = min(kq * 32 + 2 * u + par, 128); const int idx = Lb + t - r * j;
        const float* p = (idx >= Lb ? nb : cb) + (size_t)idx * 1024; kv[u] = *(const f32x4*)p; vv[u] = *(const f32x4*)(p + 512); }
    float sc = NEGBIG;
#pragma unroll
    for (int u = 0; u < 17; ++u) {
        float part = (q[0] * kv[u][0] + q[1] * kv[u][1]) + (q[2] * kv[u][2] + q[3] * kv[u][3]);
        part += __shfl_xor(part, 1); part += __shfl_xor(part, 2); part += __shfl_xor(part, 4); part += __shfl_xor(part, 8); part += __shfl_xor(part, 16);
        const int jo = 2 * u + par;
        const bool valid = jo < 32 || (jo == 32 && kq == 3);
        if (valid && hl == u) sc = part;
    }
    const float mx = wave_max(sc);
    const float pe = __builtin_amdgcn_exp2f(sc - mx);
    const float lsum = wave_sum(pe);
    f32x4 o = {0.f, 0.f, 0.f, 0.f};
#pragma unroll
    for (int u = 0; u < 17; ++u) { const float pj = __shfl(pe, par * 32 + u); o += pj * vv[u]; }
#pragma unroll
    for (int e = 0; e < 4; ++e) o[e] += __shfl_xor(o[e], 32);
    const float inv = 1.f / lsum;
    const int part_id = g * 4 + kq;
    if (par == 0) *(f32x4*)((float*)(a.ws + WS_SOG) + ((size_t)part_id * MS + rs) * 512 + h * 128 + 4 * hl) = o * inv;
    if (lane == 0) ((float*)(a.ws + WS_SL2))[((size_t)part_id * MS + rs) * 4 + h] = mx + __builtin_amdgcn_logf(lsum);
}

__device__ __forceinline__ AttnDesc item_desc(const Args& a, int mode, int it) {
    if (mode == 0) { if (it < 1536) return dil_prompt_desc(a, it); return cross_desc(a, 0, it - 1536); }
    return cross_desc(a, 1, it);
}
__device__ __forceinline__ void attn_run(const Args& a, int mode, int NI, LAS unsigned char* lds) {
    const int G = gridDim.x;
    int it = (G & 7) ? (int)blockIdx.x : (int)(blockIdx.x & 7) * (G >> 3) + (int)(blockIdx.x >> 3);
    if (it >= NI) return;
    u32x4 kr[8], vr[8];
    AttnDesc d = item_desc(a, mode, it);
    attn_load1(d.K, d.Kf, d.ks, d.jmin, kr);
    for (;;) {
        attn_stageK(kr, lds);
        attn_load1(d.V, d.Vf, d.ks, d.jmin, vr);
        bf16x8 qf[4]; attn_qload(d, qf);
        __syncthreads();
        const int nx = it + G; const bool has = nx < NI;
        const AttnDesc dn = item_desc(a, mode, has ? nx : it);
        attn_compute(d, qf, lds, has, dn, kr, vr);
        __syncthreads();
        if (!has) break;
        it = nx; d = item_desc(a, mode, it);
    }
}
__device__ __forceinline__ void phase_attn0(const Args& a, LAS unsigned char* lds) {
    const int G = gridDim.x, bx = blockIdx.x;
    constexpr int NI = 1536 + 640, NSI = DB * DS * 48;
    const int wave = threadIdx.x >> 6, lane = threadIdx.x & 63;
    if (bx & 1) win_share(a, 0, WCA);
    if (G == 256) {
        const int vb = (bx & 7) * 32 + (bx >> 3);
        if (vb >= 128) { const int base = ((vb - 128) * 8 + wave) * 4; for (int k = 0; k < 4; ++k) sample_dil_item(a, base + k, lane); }
        else { const int base = 4096 + (vb * 8 + wave) * 2; for (int k = 0; k < 2; ++k) sample_dil_item(a, base + k, lane); }
    } else { for (int wi = bx * 8 + wave; wi < NSI; wi += G * 8) sample_dil_item(a, wi, lane); }
    attn_run(a, 0, NI, lds);
    if (!(bx & 1)) win_share(a, 0, WCA);
}
__device__ __forceinline__ void phase_combine(const Args& a) {
    const size_t gtid = (size_t)blockIdx.x * 512 + threadIdx.x, nth = (size_t)gridDim.x * 512;
    const float* L2 = (const float*)(a.ws + WS_L2G); const bf16_t* OG = (const bf16_t*)(a.ws + WS_OG); bf16_t* MG = (bf16_t*)(a.ws + WS_MERGED);
    for (size_t it = gtid; it < (size_t)MP * 64; it += nth) { const size_t row = it >> 6; const int ch = (int)(it & 63), h = ch >> 4;
        const float l0 = L2[row * 4 + h], l1 = L2[(size_t)MT * 4 + row * 4 + h], l2 = L2[(size_t)2 * MT * 4 + row * 4 + h];
        const float mx = fmaxf(l0, fmaxf(l1, l2));
        float w0 = __builtin_amdgcn_exp2f(l0 - mx), w1 = __builtin_amdgcn_exp2f(l1 - mx), w2 = __builtin_amdgcn_exp2f(l2 - mx);
        const float inv = 1.f / (w0 + w1 + w2); w0 *= inv; w1 *= inv; w2 *= inv;
        const u32x4 a0 = *(const u32x4*)(OG + row * 512 + ch * 8), a1 = *(const u32x4*)(OG + (size_t)MT * 512 + row * 512 + ch * 8), a2 = *(const u32x4*)(OG + (size_t)2 * MT * 512 + row * 512 + ch * 8);
        u32x4 o;
        o.x = pk2(w0 * bflo(a0.x) + w1 * bflo(a1.x) + w2 * bflo(a2.x), w0 * bfhi(a0.x) + w1 * bfhi(a1.x) + w2 * bfhi(a2.x));
        o.y = pk2(w0 * bflo(a0.y) + w1 * bflo(a1.y) + w2 * bflo(a2.y), w0 * bfhi(a0.y) + w1 * bfhi(a1.y) + w2 * bfhi(a2.y));
        o.z = pk2(w0 * bflo(a0.z) + w1 * bflo(a1.z) + w2 * bflo(a2.z), w0 * bfhi(a0.z) + w1 * bfhi(a1.z) + w2 * bfhi(a2.z));
        o.w = pk2(w0 * bflo(a0.w) + w1 * bflo(a1.w) + w2 * bflo(a2.w), w0 * bfhi(a0.w) + w1 * bfhi(a1.w) + w2 * bfhi(a2.w));
        *(u32x4*)(MG + row * DM + ch * 8) = o; }
    const float* SL2 = (const float*)(a.ws + WS_SL2); const float* SOG = (const float*)(a.ws + WS_SOG);
    for (size_t it = gtid; it < (size_t)MS * 64; it += nth) { const int rs = (int)(it >> 6), ch = (int)(it & 63), h = ch >> 4;
        float l[12]; float mx = NEGBIG;
#pragma unroll
        for (int p = 0; p < 12; ++p) { l[p] = SL2[((size_t)p * MS + rs) * 4 + h]; mx = fmaxf(mx, l[p]); }
        float ws = 0.f;
#pragma unroll
        for (int p = 0; p < 12; ++p) { l[p] = __builtin_amdgcn_exp2f(l[p] - mx); ws += l[p]; }
        const float inv = 1.f / ws;
        f32x4 o0 = {0.f, 0.f, 0.f, 0.f}, o1 = {0.f, 0.f, 0.f, 0.f};
#pragma unroll
        for (int p = 0; p < 12; ++p) { const float* s = SOG + ((size_t)p * MS + rs) * 512 + ch * 8; o0 += l[p] * *(const f32x4*)s; o1 += l[p] * *(const f32x4*)(s + 4); }
        o0 *= inv; o1 *= inv;
        u32x4 o; o.x = pk2(o0[0], o0[1]); o.y = pk2(o0[2], o0[3]); o.z = pk2(o1[0], o1[1]); o.w = pk2(o1[2], o1[3]);
        *(u32x4*)(MG + ((size_t)MP + rs) * DM + ch * 8) = o; }
}

__device__ __forceinline__ void conv_rows(const float (&wa)[3][8], const float (&wb)[3][8], const float (&ba)[8], const float (&bb)[8],
                                          float (&a2)[8], float (&a1)[8], float (&b2)[8], float (&b1)[8], const float (&ac)[8], const float (&bc)[8], bf16_t* dst) {
    float o[8];
#pragma unroll
    for (int e = 0; e < 8; ++e) { const float A = ba[e] + wa[0][e] * a2[e] + wa[1][e] * a1[e] + wa[2][e] * ac[e]; const float B = bb[e] + wb[0][e] * b2[e] + wb[1][e] * b1[e] + wb[2][e] * bc[e];
        o[e] = A * __builtin_amdgcn_rcpf(1.f + __expf(-A)) * B; a2[e] = a1[e]; a1[e] = ac[e]; b2[e] = b1[e]; b1[e] = bc[e]; }
    u32x4 w; w.x = pk2(o[0], o[1]); w.y = pk2(o[2], o[3]); w.z = pk2(o[4], o[5]); w.w = pk2(o[6], o[7]);
    *(u32x4*)dst = w;
}
__device__ __forceinline__ void phase_conv_fix(const Args& a, int layer) {
    const size_t gtid = (size_t)blockIdx.x * 512 + threadIdx.x, nth = (size_t)gridDim.x * 512;
    const bf16_t* BND = (const bf16_t*)(a.ws + WS_BND); const bf16_t* UPS = (const bf16_t*)(a.ws + WS_UPS); bf16_t* ACT = (bf16_t*)(a.ws + WS_ACT);
    const float* cw = a.in[31] + (size_t)layer * 3 * NUP; const float* cb = a.in[32] + (size_t)layer * NUP;
    constexpr int NCC = DFF / 8;
    for (size_t it = gtid; it < (size_t)(256 + DB) * NCC; it += nth) {
        const int cc = (int)(it % NCC), k = (int)(it / NCC), col = cc * 8;
        if (k < 256 && (k & 63) == 0) continue;
        float wa[3][8], wb[3][8], ba[8], bb[8];
#pragma unroll
        for (int j = 0; j < 3; ++j) { load8f(cw + j * NUP + col, wa[j]); load8f(cw + j * NUP + DFF + col, wb[j]); }
        load8f(cb + col, ba); load8f(cb + DFF + col, bb);
        float a2[8], a1[8], b2[8], b1[8], ac[8], bc[8];
        if (k < 256) {
            const bf16_t* pv = BND + (size_t)(k - 1) * 4 * NUP; const bf16_t* cu = BND + (size_t)k * 4 * NUP;
            unpack8(*(const u32x4*)(pv + (size_t)(2 * 2 + 0) * DFF + col), a2); unpack8(*(const u32x4*)(pv + (size_t)(2 * 2 + 1) * DFF + col), b2);
            unpack8(*(const u32x4*)(pv + (size_t)(3 * 2 + 0) * DFF + col), a1); unpack8(*(const u32x4*)(pv + (size_t)(3 * 2 + 1) * DFF + col), b1);
            unpack8(*(const u32x4*)(cu + (size_t)(0 * 2 + 0) * DFF + col), ac); unpack8(*(const u32x4*)(cu + (size_t)(0 * 2 + 1) * DFF + col), bc);
            conv_rows(wa, wb, ba, bb, a2, a1, b2, b1, ac, bc, ACT + (size_t)(64 * k) * DFF + col);
            unpack8(*(const u32x4*)(cu + (size_t)(1 * 2 + 0) * DFF + col), ac); unpack8(*(const u32x4*)(cu + (size_t)(1 * 2 + 1) * DFF + col), bc);
            conv_rows(wa, wb, ba, bb, a2, a1, b2, b1, ac, bc, ACT + (size_t)(64 * k + 1) * DFF + col);
        } else {
            const int b = k - 256;
            const float* st = a.in[7] + ((size_t)layer * DB + b) * 2 * NUP;
            load8f(st + col, a2); load8f(st + NUP + col, a1); load8f(st + DFF + col, b2); load8f(st + NUP + DFF + col, b1);
#pragma unroll
            for (int t = 0; t < DS; ++t) { const bf16_t* r = UPS + (size_t)(b * DS + t) * NUP;
                unpack8(*(const u32x4*)(r + col), ac); unpack8(*(const u32x4*)(r + DFF + col), bc);
                conv_rows(wa, wb, ba, bb, a2, a1, b2, b1, ac, bc, ACT + (size_t)(MP + b * DS + t) * DFF + col); }
        }
    }
    constexpr int NC8 = NUP / 8;
    for (size_t it = gtid; it < (size_t)(NB + DB) * 2 * NC8; it += nth) {
        const int c8 = (int)(it % NC8), rr = (int)((it / NC8) & 1), sb = (int)(it / (2 * NC8));
        const bf16_t* srcp; float* dst;
        if (sb < NB) { srcp = BND + ((size_t)(sb * 64 + 63) * 4 + 2 + rr) * NUP + c8 * 8; dst = a.out + O_PCONV + (((size_t)layer * NB + sb) * 2 + rr) * NUP + c8 * 8; }
        else { const int b = sb - NB; srcp = UPS + (size_t)(b * DS + 2 + rr) * NUP + c8 * 8; dst = a.out + O_SCONV + (((size_t)layer * DB + b) * 2 + rr) * NUP + c8 * 8; }
        float x[8]; unpack8(*(const u32x4*)srcp, x);
        *(f32x4*)dst = (f32x4){x[0], x[1], x[2], x[3]}; *(f32x4*)(dst + 4) = (f32x4){x[4], x[5], x[6], x[7]};
    }
}

struct S5B { float lbr, lbi; bf16x8 bf[8], bl[8]; };
__device__ __forceinline__ void s5_lambda(float are, float aim, float dt, float& lbr, float& lbi) {
    const float mag = __expf(are * dt);
    float turns = aim * dt * 0.15915494309189535f; turns -= rintf(turns);
    lbr = mag * __builtin_amdgcn_cosf(turns); lbi = mag * __builtin_amdgcn_sinf(turns);
}
__device__ __forceinline__ void s5_consts(const Args& a, int G, int lane, S5B& c) {
    const int l16 = lane & 15, quad = lane >> 4;
    const float dt = __expf(a.in[17][G]);
    s5_lambda(a.in[15][G * 64 + lane], a.in[16][G * 64 + lane], dt, c.lbr, c.lbi);
#pragma unroll
    for (int q4 = 0; q4 < 4; ++q4) {
        const int p = 16 * q4 + l16;
        const float are = a.in[15][G * 64 + p], aim = a.in[16][G * 64 + p];
        float lr, li; s5_lambda(are, aim, dt, lr, li);
        const float den = are * are + aim * aim, xr = lr - 1.f, yi = li;
        const float fre = (xr * are + yi * aim) / den, fim = (yi * are - xr * aim) / den;
        u32x4 wr = {0u, 0u, 0u, 0u}, wi = {0u, 0u, 0u, 0u}, lr4 = {0u, 0u, 0u, 0u}, li4 = {0u, 0u, 0u, 0u};
        if (quad < 2) { float br[8], bi[8]; load8f(a.in[18] + (size_t)(G * 64 + p) * 16 + quad * 8, br); load8f(a.in[19] + (size_t)(G * 64 + p) * 16 + quad * 8, bi);
            float r[8], i[8];
#pragma unroll
            for (int e = 0; e < 8; ++e) { r[e] = fre * br[e] - fim * bi[e]; i[e] = fre * bi[e] + fim * br[e]; }
            wr.x = pk2(r[0], r[1]); wr.y = pk2(r[2], r[3]); wr.z = pk2(r[4], r[5]); wr.w = pk2(r[6], r[7]);
            wi.x = pk2(i[0], i[1]); wi.y = pk2(i[2], i[3]); wi.z = pk2(i[4], i[5]); wi.w = pk2(i[6], i[7]);
            float rh[8], ih[8]; unpack8(wr, rh); unpack8(wi, ih);
#pragma unroll
            for (int e = 0; e < 8; ++e) { r[e] -= rh[e]; i[e] -= ih[e]; }
            lr4.x = pk2(r[0], r[1]); lr4.y = pk2(r[2], r[3]); lr4.z = pk2(r[4], r[5]); lr4.w = pk2(r[6], r[7]);
            li4.x = pk2(i[0], i[1]); li4.y = pk2(i[2], i[3]); li4.z = pk2(i[4], i[5]); li4.w = pk2(i[6], i[7]); }
        c.bf[q4] = __builtin_bit_cast(bf16x8, wr); c.bf[4 + q4] = __builtin_bit_cast(bf16x8, wi);
        c.bl[q4] = __builtin_bit_cast(bf16x8, lr4); c.bl[4 + q4] = __builtin_bit_cast(bf16x8, li4);
    }
}
__device__ __forceinline__ void s5_bu16(const S5B& c, const LAS bf16_t* ub, int sub, LAS float* bul, int lane) {
    const int l16 = lane & 15, quad = lane >> 4;
    u32x4 aw = {0u, 0u, 0u, 0u};
    if (quad < 2) aw = *(const LAS u32x4*)(ub + (sub * 16 + l16) * 16 + quad * 8);
    const bf16x8 af = __builtin_bit_cast(bf16x8, aw);
    f32x4 d[8];
#pragma unroll
    for (int nt = 0; nt < 8; ++nt) { d[nt] = __builtin_amdgcn_mfma_f32_16x16x32_bf16(af, c.bl[nt], (f32x4){0.f, 0.f, 0.f, 0.f}, 0, 0, 0); d[nt] = __builtin_amdgcn_mfma_f32_16x16x32_bf16(af, c.bf[nt], d[nt], 0, 0, 0); }
    asm volatile("s_nop 15\n\ts_nop 15" : "+v"(d[0]), "+v"(d[1]), "+v"(d[2]), "+v"(d[3]), "+v"(d[4]), "+v"(d[5]), "+v"(d[6]), "+v"(d[7]));
#pragma unroll
    for (int nt = 0; nt < 8; ++nt)
#pragma unroll
        for (int j = 0; j < 4; ++j) bul[(quad * 4 + j) * 132 + 16 * nt + l16] = d[nt][j];
    LDS_WAIT();
}
__device__ __forceinline__ void s5_stage_u(const bf16_t* up, int nst, LAS bf16_t* ub, int lane) {
    u32x4 w0 = {0u, 0u, 0u, 0u}, w1 = {0u, 0u, 0u, 0u};
    if (lane < nst) { w0 = *(const u32x4*)(up + (size_t)lane * DM); w1 = *(const u32x4*)(up + (size_t)lane * DM + 8); }
    *(LAS u32x4*)(ub + lane * 16) = w0; *(LAS u32x4*)(ub + lane * 16 + 8) = w1;
    LDS_WAIT();
}
__device__ __forceinline__ void phase_s5_pass1(const Args& a, LAS unsigned char* lds) {
    const int lane = threadIdx.x & 63, wave = threadIdx.x >> 6;
    const int gw = blockIdx.x * 8 + wave, NGW = gridDim.x * 8;
    const bf16_t* P1 = (const bf16_t*)(a.ws + WS_PROJ1); f32x2* E = (f32x2*)(a.ws + WS_E);
    LAS bf16_t* ub = (LAS bf16_t*)(lds + wave * 16384 + 4608);
    LAS float* bul = (LAS float*)(lds + wave * 16384 + 6656);
    for (int wi = gw; wi < NB * 63 * 32; wi += NGW) {
        const int G = wi & 31, ch = (wi >> 5) % 63, b = (wi >> 5) / 63;
        s5_stage_u(P1 + ((size_t)b * SEQ + ch * 64) * DM + G * 16, 64, ub, lane);
        S5B c; s5_consts(a, G, lane, c);
        float sr = 0.f, si = 0.f;
        for (int sub = 0; sub < 4; ++sub) {
            s5_bu16(c, ub, sub, bul, lane);
#pragma unroll
            for (int tl = 0; tl < 16; ++tl) { const float br = bul[tl * 132 + lane], bi = bul[tl * 132 + 64 + lane];
                const float nr = c.lbr * sr - c.lbi * si + br, ni = c.lbr * si + c.lbi * sr + bi; sr = nr; si = ni; }
            LDS_WAIT();
        }
        E[(((size_t)b * 64 + ch) * 32 + G) * 64 + lane] = (f32x2){sr, si};
    }
}
__device__ __forceinline__ void phase_s5_pass2(const Args& a, LAS unsigned char* lds) {
    const int lane = threadIdx.x & 63, wave = threadIdx.x >> 6, l16 = lane & 15, quad = lane >> 4;
    const int gw = blockIdx.x * 8 + wave, NGW = gridDim.x * 8;
    const bf16_t* P1 = (const bf16_t*)(a.ws + WS_PROJ1); const f32x2* E = (const f32x2*)(a.ws + WS_E); bf16_t* Y = (bf16_t*)(a.ws + WS_Y);
    LAS bf16_t* st = (LAS bf16_t*)(lds + wave * 16384);
    LAS bf16_t* ub = (LAS bf16_t*)(lds + wave * 16384 + 4608);
    LAS float* bul = (LAS float*)(lds + wave * 16384 + 6656);
    for (int wi = gw; wi < NB * 64 * 32 + DB * 32; wi += NGW) {
        const bool prompt = wi < NB * 64 * 32;
        int G, ch, b; size_t row0;
        if (prompt) { G = wi & 31; ch = (wi >> 5) & 63; b = wi >> 11; row0 = (size_t)b * SEQ + ch * 64; }
        else { const int x = wi - NB * 64 * 32; G = x & 31; b = x >> 5; ch = 0; row0 = (size_t)MP + b * DS; }
        const int nsub = prompt ? 4 : 1, nst = prompt ? 16 : DS;
        s5_stage_u(P1 + row0 * DM + G * 16, prompt ? 64 : DS, ub, lane);
        S5B c; s5_consts(a, G, lane, c);
        float sr, si;
        if (prompt) {
            float pr = c.lbr, pi = c.lbi;
#pragma unroll
            for (int q = 0; q < 6; ++q) { const float nr = pr * pr - pi * pi, ni = 2.f * pr * pi; pr = nr; pi = ni; }
            sr = 0.f; si = 0.f;
            const f32x2* Eb = E + (((size_t)b * 64) * 32 + G) * 64 + lane;
            int j = 0;
            for (; j + 8 <= ch; j += 8) { f32x2 e[8];
#pragma unroll
                for (int u = 0; u < 8; ++u) e[u] = Eb[(size_t)(j + u) * 2048];
#pragma unroll
                for (int u = 0; u < 8; ++u) { const float nr = pr * sr - pi * si + e[u][0], ni = pr * si + pi * sr + e[u][1]; sr = nr; si = ni; } }
            for (; j < ch; ++j) { const f32x2 e = Eb[(size_t)j * 2048]; const float nr = pr * sr - pi * si + e[0], ni = pr * si + pi * sr + e[1]; sr = nr; si = ni; }
        } else { sr = a.in[6][(((size_t)b * 2 + 0) * 32 + G) * 64 + lane]; si = a.in[6][(((size_t)b * 2 + 1) * 32 + G) * 64 + lane]; }
        bf16x8 cf[4];
#pragma unroll
        for (int ks = 0; ks < 4; ++ks) { const int k0 = ks * 32 + quad * 8; float v[8];
            if (k0 < 64) load8f(a.in[20] + (size_t)(G * 16 + l16) * 64 + k0, v);
            else { load8f(a.in[21] + (size_t)(G * 16 + l16) * 64 + (k0 - 64), v);
#pragma unroll
                for (int e = 0; e < 8; ++e) v[e] = -v[e]; }
            u32x4 t; t.x = pk2(v[0], v[1]); t.y = pk2(v[2], v[3]); t.z = pk2(v[4], v[5]); t.w = pk2(v[6], v[7]); cf[ks] = __builtin_bit_cast(bf16x8, t); }
        const float dsk = a.in[22][G * 16 + l16];
        for (int sub = 0; sub < nsub; ++sub) {
            const size_t rbase = row0 + sub * 16;
            s5_bu16(c, ub, sub, bul, lane);
#pragma unroll 4
            for (int tl = 0; tl < nst; ++tl) {
                const float br = bul[tl * 132 + lane], bi = bul[tl * 132 + 64 + lane];
                const float nr = c.lbr * sr - c.lbi * si + br, ni = c.lbr * si + c.lbi * sr + bi; sr = nr; si = ni;
                st[tl * 136 + lane] = f2bf(sr); st[tl * 136 + 64 + lane] = f2bf(si);
            }
            LDS_WAIT();
            f32x4 acc = {0.f, 0.f, 0.f, 0.f};
#pragma unroll
            for (int ks = 0; ks < 4; ++ks) { const bf16x8 af = *(const LAS bf16x8*)(st + l16 * 136 + ks * 32 + quad * 8);
                acc = __builtin_amdgcn_mfma_f32_16x16x32_bf16(af, cf[ks], acc, 0, 0, 0); }
#pragma unroll
            for (int j = 0; j < 4; ++j) { const int t = quad * 4 + j;
                if (t < nst) { const size_t row = rbase + t;
                    const float uval = bf2f(ub[(sub * 16 + t) * 16 + l16]);
                    const float y = acc[j] + dsk * uval;
                    const float z2 = 1.5957691216057308f * (y + 0.044715f * y * y * y);
                    Y[row * 512 + G * 16 + l16] = f2bf(y * __builtin_amdgcn_rcpf(1.f + __expf(-z2))); } }
            LDS_WAIT();
        }
        if (prompt) { if (ch == 63) { a.out[O_PS5 + (((size_t)b * 2 + 0) * 32 + G) * 64 + lane] = sr; a.out[O_PS5 + (((size_t)b * 2 + 1) * 32 + G) * 64 + lane] = si; } }
        else { a.out[O_SS5 + (((size_t)b * 2 + 0) * 32 + G) * 64 + lane] = sr; a.out[O_SS5 + (((size_t)b * 2 + 1) * 32 + G) * 64 + lane] = si; }
    }
}

#define XB_TMO      128
#define XB_XCNT(j)  (256  + 64 * (j))
#define XB_XSUB(j)  (1280 + 64 * (j))
#define XB_XGEN(j)  (2304 + 64 * (j))
#define XB_TOP      3328
#define XB_TOPGEN   3392
#define XCD_BAR_WORDS 3456
#define XB_SPIN_CAP (1u << 18)

__device__ __forceinline__ unsigned xb_ld(unsigned* p)              { return __hip_atomic_load(p, __ATOMIC_RELAXED, __HIP_MEMORY_SCOPE_AGENT); }
__device__ __forceinline__ unsigned xb_add(unsigned* p, unsigned v) { return __hip_atomic_fetch_add(p, v, __ATOMIC_RELAXED, __HIP_MEMORY_SCOPE_AGENT); }
__device__ __forceinline__ unsigned xb_xcc_id() { return (unsigned)__builtin_amdgcn_s_getreg((3 << 11) | 20) & 0xFu; }
#define XB_SPIN(cond, bar) do { unsigned _sp = 0; while (cond) { __builtin_amdgcn_s_sleep(16); \
    if ((++_sp & 255u) == 0u) { if (xb_ld(&(bar)[XB_TMO])) break; if (_sp > XB_SPIN_CAP) { atomicAdd(&(bar)[XB_TMO], 1u); break; } } } } while (0)

struct XcdBarrier {
    unsigned* bar; unsigned x;
    volatile LAS unsigned* st;
};

__device__ __forceinline__ XcdBarrier xcd_barrier_post(unsigned* bar, volatile LAS unsigned* st) {
    XcdBarrier b; b.bar = bar; b.x = xb_xcc_id(); b.st = st;
    if (threadIdx.x == 0) (void)xb_add(&bar[XB_XCNT(b.x)], 1u);
    return b;
}
__device__ __forceinline__ void xcd_barrier_complete(unsigned* bar, unsigned x, unsigned& nloc, unsigned& nx) {
    const unsigned G = gridDim.x * gridDim.y * gridDim.z;
    unsigned sum, cnt, mine, sp = 0u;
    for (;;) {
        sum = 0u; cnt = 0u; mine = 0u;
#pragma unroll
        for (unsigned j = 0; j < 16; ++j) { const unsigned c = xb_ld(&bar[XB_XCNT(j)]); sum += c; cnt += (c > 0u) ? 1u : 0u; mine = (j == x) ? c : mine; }
        if (sum == G) break;
        __builtin_amdgcn_s_sleep(1);
        if ((++sp & 255u) == 0u) { if (xb_ld(&bar[XB_TMO])) break; if (sp > XB_SPIN_CAP) { atomicAdd(&bar[XB_TMO], 1u); break; } }
    }
    nloc = mine > 0u ? mine : 1u; nx = cnt > 0u ? cnt : 1u;
}

__device__ __forceinline__ void xcd_barrier(const XcdBarrier& b) {
    asm volatile("s_waitcnt vmcnt(0)" ::: "memory");
    __syncthreads();
    if (threadIdx.x == 0) {
        unsigned* bar = b.bar;
        __builtin_amdgcn_s_waitcnt(0);
        unsigned nloc = b.st[0], nx = b.st[1];
        if (nloc == 0u) { xcd_barrier_complete(bar, b.x, nloc, nx); b.st[0] = nloc; b.st[1] = nx; }
        const unsigned old = xb_add(&bar[XB_XSUB(b.x)], 1u);
        const unsigned gen = old / nloc;
        if (old + 1u == (gen + 1u) * nloc) {
            __builtin_amdgcn_fence(__ATOMIC_RELEASE, "agent");
            asm volatile("s_waitcnt vmcnt(0)" ::: "memory");
            const unsigned og = xb_add(&bar[XB_TOP], 1u);
            const unsigned tg = og / nx;
            if (og + 1u == (tg + 1u) * nx) xb_add(&bar[XB_TOPGEN], 1u);
            else XB_SPIN(xb_ld(&bar[XB_TOPGEN]) == tg, bar);
            __builtin_amdgcn_fence(__ATOMIC_ACQUIRE, "agent");
            xb_add(&bar[XB_XGEN(b.x)], 1u);
            asm volatile("s_waitcnt vmcnt(0)" ::: "memory");
        } else {
            XB_SPIN(xb_ld(&bar[XB_XGEN(b.x)]) == gen, bar);
            __builtin_amdgcn_fence(__ATOMIC_ACQUIRE, "agent");
            asm volatile("s_waitcnt vmcnt(0)" ::: "memory");
        }
    }
    __syncthreads();
}

constexpr int NPHASE = 17;
#define GEMM_CALL(EpiT, gdesc, sched, epi) pg8::gemm_phase<EpiT, pg8::StaticOrder, true, true>(lds, gdesc, sched, epi)

__global__ void __launch_bounds__(512, 2) trunk_fwd(Args a) {
    extern __shared__ __attribute__((aligned(16))) unsigned char lds_raw[];
    LAS unsigned char* lds = (LAS unsigned char*)lds_raw;
    cg::grid_group grid = cg::this_grid();
    const int lo = a.ph_lo, hi = a.ph_hi;
    const int G = gridDim.x, bx = blockIdx.x;
    const int wave = threadIdx.x >> 6, lane = threadIdx.x & 63;
    const int gw = bx * 8 + wave, NGW = G * 8;
    unsigned char* ws = a.ws;
    bf16_t* HB = (bf16_t*)(ws + WS_HB);
    float* SUMSQ = (float*)(ws + WS_SUMSQ);
    float* X = (float*)(ws + WS_X);
#define IN(k) (lo <= (k) && (k) < hi)
    volatile LAS unsigned* bst = (volatile LAS unsigned*)(lds + 131072);
    if (threadIdx.x < 2) bst[threadIdx.x] = 0u;
    __syncthreads();
    XcdBarrier xbar = xcd_barrier_post((unsigned*)(ws + WS_BAR), bst);
    if (lo < 0) grid.sync();
#define SEAM(k) do { if (IN(k) && IN((k) + 1)) xcd_barrier(xbar); } while (0)

    if (IN(0)) { phase_prep(a, lds); __syncthreads(); }
    SEAM(0);
    if (IN(1)) {
        { pg8::Gemm g{HB, (const bf16_t*)(ws + WS_WINA), MP, NIN_A, DM}; pg8::StaticOrder S; S.init(MP, NIN_A, G, bx);
          EpiStoreBf16 E{(bf16_t*)(ws + WS_PROJ), NIN_A, nullptr}; GEMM_CALL(EpiStoreBf16, g, S, E); }
        { SkStore F{(bf16_t*)(ws + WS_PROJ), NIN_A, nullptr}; skinny_gemm(HB, (const bf16_t*)(ws + WS_WINA), DM, NIN_A, F); }
        win_idle(a, WCC, WCD, 32);
        for (int i = 0; i < 2; ++i) {
            pg8::Gemm g{(const bf16_t*)(ws + WS_MEMN) + (size_t)i * DM * DM, (const bf16_t*)(ws + WS_WMKV) + (size_t)i * DM * DM, 1024, 1024, DM};
            pg8::StaticOrder S; S.init(1024, 1024, G, (bx + 2 * G - 16 * i) % G);
            EpiStoreBf16 E{(bf16_t*)(ws + WS_MKVR) + (size_t)i * DM * DM, DM, nullptr}; GEMM_CALL(EpiStoreBf16, g, S, E); }
    }
    SEAM(1);
    if (IN(2)) {
        for (int m = gw; m < MT + 2048; m += NGW) { if (m < MT) p2_row(a, m, lane); else p2_memrow(a, m - MT, lane); }
    }
    SEAM(2);
    if (IN(3)) phase_attn0(a, lds);
    SEAM(3);
    if (IN(4)) phase_combine(a);
    SEAM(4);
    if (IN(5)) {
        pg8::Gemm g{(const bf16_t*)(ws + WS_MERGED), (const bf16_t*)(ws + WS_WOUT), MP, DM, DM}; pg8::StaticOrder S; S.init(MP, DM, G, bx);
        EpiResidual E{a.in[0], a.in[1], X, X + (size_t)MP * DM, SUMSQ, HB, a.in[10]}; GEMM_CALL(EpiResidual, g, S, E);
        SkResidual F{a.in[1], X + (size_t)MP * DM, SUMSQ, HB, a.in[10]}; skinny_gemm_splitk((const bf16_t*)(ws + WS_MERGED), (const bf16_t*)(ws + WS_WOUT), DM, DM, F, lds); }
    SEAM(5);
    if (IN(6)) {
        pg8::Gemm g{HB, (const bf16_t*)(ws + WS_WUP), MPAD, NUP, DM}; pg8::StaticOrder S; S.init(MPAD, NUP, G, bx);
        EpiUpConv E{(bf16_t*)(ws + WS_ACT), SUMSQ, a.in[31], a.in[32], (bf16_t*)(ws + WS_BND), (bf16_t*)(ws + WS_UPS)}; GEMM_CALL(EpiUpConv, g, S, E);
        win_idle(a, WCD, WCE, (MPAD / 256) * (NUP / 256) % G); }
    SEAM(6);
    if (IN(7)) phase_conv_fix(a, 0);
    SEAM(7);
    if (IN(8)) {
        pg8::Gemm g{(const bf16_t*)(ws + WS_ACT), (const bf16_t*)(ws + WS_WDN), MP, DM, DFF}; pg8::StaticOrder S; S.init(MP, DM, G, bx);
        EpiResidual E{X, X + (size_t)MP * DM, X, X + (size_t)MP * DM, SUMSQ + MPAD, HB, a.in[9] + DM}; GEMM_CALL(EpiResidual, g, S, E);
        SkResidual F{X + (size_t)MP * DM, X + (size_t)MP * DM, SUMSQ + MPAD, HB, a.in[9] + DM}; skinny_gemm_splitk((const bf16_t*)(ws + WS_ACT), (const bf16_t*)(ws + WS_WDN), DFF, DM, F, lds); }
    SEAM(8);
    if (IN(9)) {
        pg8::Gemm g{HB, (const bf16_t*)(ws + WS_WINB), MP, DM, DM}; pg8::StaticOrder S; S.init(MP, DM, G, bx);
        EpiStoreBf16 E{(bf16_t*)(ws + WS_PROJ1), DM, SUMSQ + MPAD}; GEMM_CALL(EpiStoreBf16, g, S, E);
        SkStore F{(bf16_t*)(ws + WS_PROJ1), DM, SUMSQ + MPAD}; skinny_gemm_splitk(HB, (const bf16_t*)(ws + WS_WINB), DM, DM, F, lds); }
    SEAM(9);
    if (IN(10)) {
        if (bx & 1) win_share(a, WCA, WCB);
        attn_run(a, 1, 640, lds);
        phase_s5_pass1(a, lds);
        if (!(bx & 1)) win_share(a, WCA, WCB);
    }
    SEAM(10);
    if (IN(11)) { if (bx & 1) win_share(a, WCB, WCC); phase_s5_pass2(a, lds); __syncthreads(); if (!(bx & 1)) win_share(a, WCB, WCC); }
    SEAM(11);
    if (IN(12)) {
        pg8::Gemm g{(const bf16_t*)(ws + WS_Y), (const bf16_t*)(ws + WS_WGLU), MP, 512, 512}; pg8::StaticOrder S; S.init(MP, 512, G, bx);
        EpiGlu E{(bf16_t*)(ws + WS_MERGED), DM, (const bf16_t*)(ws + WS_Y), a.in[24]}; GEMM_CALL(EpiGlu, g, S, E);
        SkGlu F{(bf16_t*)(ws + WS_MERGED), DM, (const bf16_t*)(ws + WS_Y), a.in[24]}; skinny_gemm_splitk((const bf16_t*)(ws + WS_Y), (const bf16_t*)(ws + WS_WGLU), 512, 512, F, lds);
        if (bx >= 128 && G > 128) win_copy<2048>(a.in[4], a.out + O_SW2, W2_A, W2_B, (size_t)(bx - 128) * 512 + threadIdx.x, (size_t)(G - 128) * 512); }
    SEAM(12);
    if (IN(13)) {
        pg8::Gemm g{(const bf16_t*)(ws + WS_MERGED), (const bf16_t*)(ws + WS_WOUT) + (size_t)DM * DM, MP, DM, DM}; pg8::StaticOrder S; S.init(MP, DM, G, bx);
        EpiResidual E{X, X + (size_t)MP * DM, X, X + (size_t)MP * DM, SUMSQ + 2 * MPAD, HB, a.in[10] + DM}; GEMM_CALL(EpiResidual, g, S, E);
        SkResidual F{X + (size_t)MP * DM, X + (size_t)MP * DM, SUMSQ + 2 * MPAD, HB, a.in[10] + DM}; skinny_gemm_splitk((const bf16_t*)(ws + WS_MERGED), (const bf16_t*)(ws + WS_WOUT) + (size_t)DM * DM, DM, DM, F, lds); }
    SEAM(13);
    if (IN(14)) {
        pg8::Gemm g{HB, (const bf16_t*)(ws + WS_WUP) + (size_t)NUP * DM, MPAD, NUP, DM}; pg8::StaticOrder S; S.init(MPAD, NUP, G, bx);
        EpiUpConv E{(bf16_t*)(ws + WS_ACT), SUMSQ + 2 * MPAD, a.in[31] + (size_t)3 * NUP, a.in[32] + NUP, (bf16_t*)(ws + WS_BND), (bf16_t*)(ws + WS_UPS)}; GEMM_CALL(EpiUpConv, g, S, E);
        win_idle(a, WCE, WCT, (MPAD / 256) * (NUP / 256) % G); }
    SEAM(14);
    if (IN(15)) phase_conv_fix(a, 1);
    SEAM(15);
    if (IN(16)) {
        pg8::Gemm g{(const bf16_t*)(ws + WS_ACT), (const bf16_t*)(ws + WS_WDN) + (size_t)DM * DFF, MP, DM, DFF}; pg8::StaticOrder S; S.init(MP, DM, G, bx);
        EpiResidual E{X, X + (size_t)MP * DM, a.out + O_YP, a.out + O_YS, nullptr, nullptr, nullptr}; GEMM_CALL(EpiResidual, g, S, E);
        SkResidual F{X + (size_t)MP * DM, a.out + O_YS, nullptr, nullptr, nullptr}; skinny_gemm_splitk((const bf16_t*)(ws + WS_ACT), (const bf16_t*)(ws + WS_WDN) + (size_t)DM * DFF, DFF, DM, F, lds); }
#undef IN
#undef SEAM
}

extern "C" void kernel_launch(void* const* d_in, const int* in_sizes, int n_in, void* d_out, int out_size, void* d_ws, size_t ws_size, hipStream_t stream) {
    static int grid = 0;
    if (grid == 0) {
        if (n_in != 34 || (size_t)out_size != O_END || ws_size < WS_END) { fprintf(stderr, "kernel_launch: unexpected shapes (n_in %d, out %d, ws %zu)\n", n_in, out_size, ws_size); grid = -1; return; }
        int dev = 0, cus = 0, per_cu = 0;
        if (hipGetDevice(&dev) != hipSuccess || hipDeviceGetAttribute(&cus, hipDeviceAttributeMultiprocessorCount, dev) != hipSuccess) { grid = -1; return; }
        if (hipFuncSetAttribute((const void*)trunk_fwd, hipFuncAttributeMaxDynamicSharedMemorySize, LDS_BYTES) != hipSuccess) { fprintf(stderr, "kernel_launch: hipFuncSetAttribute failed\n"); grid = -1; return; }
        if (hipOccupancyMaxActiveBlocksPerMultiprocessor(&per_cu, (const void*)trunk_fwd, 512, LDS_BYTES) != hipSuccess || per_cu < 1) { fprintf(stderr, "kernel_launch: occupancy query says %d\n", per_cu); grid = -1; (void)hipGetLastError(); return; }
        grid = cus * per_cu;
    }
    if (grid < 0) return;
    Args a{};
    for (int i = 0; i < 34; ++i) a.in[i] = (const float*)d_in[i];
    a.out = (float*)d_out; a.ws = (unsigned char*)d_ws;
#if MK_N_LAUNCHES == 1
    a.ph_lo = 0; a.ph_hi = NPHASE;
    if (hipMemsetAsync((char*)d_ws + WS_BAR, 0, 16384, stream) != hipSuccess) { fprintf(stderr, "kernel_launch: memset failed\n"); return; }
    void* args[] = {&a};
    hipError_t e = hipLaunchCooperativeKernel((const void*)trunk_fwd, dim3(grid), dim3(512), args, LDS_BYTES, stream);
    if (e != hipSuccess) fprintf(stderr, "kernel_launch: cooperative launch failed: %s (grid %d)\n", hipGetErrorString(e), grid);
#else
    for (int p = 0; p < NPHASE; ++p) { a.ph_lo = p; a.ph_hi = p + 1; hipLaunchKernelGGL(trunk_fwd, dim3(grid), dim3(512), LDS_BYTES, stream, a); }
#endif
}
```
